# Optimizing an MI355X kernel written in HIP

```python
import jax, jax.numpy as jnp
from jax import lax
import numpy as np

D_MODEL = 1024
BATCH = 4
SEQ = 4096
DEPTH = 1
DEC_BATCH = 8
DEC_SEQ = 8192
PAST_LEN = 128

N_FOURIER_GROUPS = 4
FOURIER_GROUP_DIM = 128
FOURIER_WIDTH = N_FOURIER_GROUPS * FOURIER_GROUP_DIM
N_RET_HEADS = 8
RET_QK_DIM = 64
RET_V_DIM = 128
RET_QK_WIDTH = N_RET_HEADS * RET_QK_DIM
RET_V_WIDTH = N_RET_HEADS * RET_V_DIM
CHUNK = 128
ROPE_THETA = 10000.0
D_FF = 2816
CONV_WIDTH = 3
NORM_EPS = 1e-6
GN_EPS = 1e-5
IN_SPLITS = [FOURIER_WIDTH, RET_QK_WIDTH, RET_QK_WIDTH, RET_V_WIDTH, RET_V_WIDTH, D_MODEL, D_MODEL]
IN_WIDTH = sum(IN_SPLITS)

kernel_name = "hybrid_fnet_retention_convglu_encoder"


def rms_norm(x, g):
    xf = x.astype(jnp.float32)
    y = xf * lax.rsqrt(jnp.mean(xf * xf, axis=-1, keepdims=True) + NORM_EPS)
    return (y * g.astype(jnp.float32)).astype(x.dtype)


def rotary(x):
    s, d = x.shape[1], x.shape[-1]
    inv = ROPE_THETA ** (-jnp.arange(0, d, 2, dtype=jnp.float32) / d)
    ang = jnp.arange(s, dtype=jnp.float32)[:, None] * inv[None, :]
    cos = jnp.cos(ang)[None, :, None, :]
    sin = jnp.sin(ang)[None, :, None, :]
    xf = x.astype(jnp.float32)
    x1, x2 = xf[..., : d // 2], xf[..., d // 2:]
    return jnp.concatenate([x1 * cos - x2 * sin, x1 * sin + x2 * cos], axis=-1)


def fourier_mix(f):
    b, s, _ = f.shape
    fg = f.reshape(b, s, N_FOURIER_GROUPS, FOURIER_GROUP_DIM).astype(jnp.float32)
    y = jnp.fft.fft2(fg, axes=(1, 3), norm="ortho").real
    return y.reshape(b, s, FOURIER_WIDTH).astype(f.dtype)


def retention_direction(q, k, v, log_gamma, include_diag):
    b, s, h, dk = q.shape
    dv = v.shape[-1]
    n_chunks = s // CHUNK

    def chunks(t):
        return t.reshape(b, n_chunks, CHUNK, h, t.shape[-1]).transpose(1, 0, 3, 2, 4)

    qc, kc, vc = chunks(q), chunks(k), chunks(v)
    pos = jnp.arange(CHUNK, dtype=jnp.float32)
    diff = pos[:, None] - pos[None, :]
    mask = (diff >= 0) if include_diag else (diff > 0)
    inner_decay = jnp.where(mask[None], jnp.exp(log_gamma[:, None, None] * jnp.maximum(diff, 0.0)[None]), 0.0)
    q_decay = jnp.exp(log_gamma[:, None] * (pos + 1.0)[None])[..., None]
    k_decay = jnp.exp(log_gamma[:, None] * (CHUNK - 1.0 - pos)[None])[..., None]
    chunk_decay = jnp.exp(log_gamma * CHUNK)[:, None, None]

    def step(state, inp):
        qi, ki, vi = inp
        scores = jnp.einsum('bhqd,bhkd->bhqk', qi, ki) * inner_decay
        o = jnp.einsum('bhqk,bhke->bhqe', scores, vi) + jnp.einsum('bhqd,bhde->bhqe', qi * q_decay, state)
        state = chunk_decay * state + jnp.einsum('bhkd,bhke->bhde', ki * k_decay, vi)
        return state, o

    s0 = jnp.zeros((b, h, dk, dv), jnp.float32)
    _, o = lax.scan(step, s0, (qc, kc, vc))
    return o.transpose(1, 0, 3, 2, 4).reshape(b, s, h, dv)


def bidirectional_retention(q, k, v, g, decay_logit):
    b, s = q.shape[0], q.shape[1]
    log_gamma = jax.nn.log_sigmoid(decay_logit.astype(jnp.float32))
    qr = rotary(q) * (RET_QK_DIM ** -0.5)
    kr = rotary(k)
    vf = v.reshape(b, s, N_RET_HEADS, RET_V_DIM).astype(jnp.float32)
    o_fwd = retention_direction(qr, kr, vf, log_gamma[0], True)
    o_bwd = retention_direction(qr[:, ::-1], kr[:, ::-1], vf[:, ::-1], log_gamma[1], False)[:, ::-1]
    o = o_fwd + o_bwd
    mu = jnp.mean(o, axis=-1, keepdims=True)
    var = jnp.mean(jnp.square(o - mu), axis=-1, keepdims=True)
    o = (o - mu) * lax.rsqrt(var + GN_EPS)
    return o.reshape(b, s, RET_V_WIDTH).astype(v.dtype) * jax.nn.silu(g)


def encoder_layer(x, norm1_g, w_in, w_four_proj, w_ret_proj, w_out, ret_decay_logit,
                  norm2_g, w_up, conv_w, conv_b, w_down):
    b, s, _ = x.shape
    u = rms_norm(x, norm1_g)
    proj = u @ w_in
    f, q, k, v, g_ret, g_a, g_b = jnp.split(proj, list(np.cumsum(IN_SPLITS[:-1])), axis=-1)
    branch_a = fourier_mix(f) @ w_four_proj
    q = q.reshape(b, s, N_RET_HEADS, RET_QK_DIM)
    k = k.reshape(b, s, N_RET_HEADS, RET_QK_DIM)
    branch_b = bidirectional_retention(q, k, v, g_ret, ret_decay_logit) @ w_ret_proj
    merged = jax.nn.sigmoid(g_a) * branch_a + jax.nn.sigmoid(g_b) * branch_b
    x = x + merged @ w_out
    u2 = rms_norm(x, norm2_g)
    h_gate, h_val = jnp.split(u2 @ w_up, 2, axis=-1)
    hp = jnp.pad(h_gate, ((0, 0), (1, 1), (0, 0)))
    h_conv = hp[:, :-2] * conv_w[0] + hp[:, 1:-1] * conv_w[1] + hp[:, 2:] * conv_w[2] + conv_b
    x = x + (jax.nn.gelu(h_conv, approximate=False) * h_val) @ w_down
    return x


def setup_inputs(seed: int = 0) -> dict:
    key = jax.random.key(seed)
    ks = jax.random.split(key, 16)
    f32 = jnp.float32
    gamma0 = 1.0 - 2.0 ** (-5.0 - np.arange(N_RET_HEADS, dtype=np.float32))
    logit0 = jnp.asarray(np.log(gamma0 / (1.0 - gamma0)).astype(np.float32))
    decay_logit = logit0[None, None, :] + 0.05 * jax.random.normal(ks[7], (DEPTH, 2, N_RET_HEADS), f32)
    return {
        "x_prompt": jax.random.normal(ks[0], (BATCH, SEQ, D_MODEL), f32),
        "x_sample": jax.random.normal(ks[1], (DEC_BATCH, DEC_SEQ, D_MODEL), f32),
        "norm1_g": 1.0 + 0.02 * jax.random.normal(ks[2], (DEPTH, D_MODEL), f32),
        "w_in": jax.random.normal(ks[3], (DEPTH, D_MODEL, IN_WIDTH), f32) * D_MODEL ** -0.5,
        "w_four_proj": jax.random.normal(ks[4], (DEPTH, FOURIER_WIDTH, D_MODEL), f32) * FOURIER_WIDTH ** -0.5,
        "w_ret_proj": jax.random.normal(ks[5], (DEPTH, RET_V_WIDTH, D_MODEL), f32) * RET_V_WIDTH ** -0.5,
        "w_out": jax.random.normal(ks[6], (DEPTH, D_MODEL, D_MODEL), f32) * D_MODEL ** -0.5,
        "ret_decay_logit": decay_logit,
        "norm2_g": 1.0 + 0.02 * jax.random.normal(ks[8], (DEPTH, D_MODEL), f32),
        "w_up": jax.random.normal(ks[9], (DEPTH, D_MODEL, 2 * D_FF), f32) * D_MODEL ** -0.5,
        "conv_w": jax.random.normal(ks[10], (DEPTH, CONV_WIDTH, D_FF), f32) * CONV_WIDTH ** -0.5,
        "conv_b": 0.01 * jax.random.normal(ks[11], (DEPTH, D_FF), f32),
        "w_down": jax.random.normal(ks[12], (DEPTH, D_FF, D_MODEL), f32) * D_FF ** -0.5,
        "final_norm_g": 1.0 + 0.02 * jax.random.normal(ks[13], (D_MODEL,), f32),
    }


def reference(x_prompt, x_sample, norm1_g, w_in, w_four_proj, w_ret_proj, w_out, ret_decay_logit,
              norm2_g, w_up, conv_w, conv_b, w_down, final_norm_g):
    def trunk(x):
        for l in range(DEPTH):
            x = encoder_layer(x, norm1_g[l], w_in[l], w_four_proj[l], w_ret_proj[l], w_out[l],
                              ret_decay_logit[l], norm2_g[l], w_up[l], conv_w[l], conv_b[l], w_down[l])
        return rms_norm(x, final_norm_g)

    y_prompt = trunk(x_prompt)
    y_sample = trunk(x_sample)
    return (y_prompt, y_sample)
```

```cpp
#include <hip/hip_runtime.h>
#include <hip/hip_cooperative_groups.h>
#include <cstdio>
#include <cstdint>
#include <cmath>
namespace cg = cooperative_groups;

#ifndef MK_N_LAUNCHES
#define MK_N_LAUNCHES 1
#endif

namespace pg8 {
#define PG8_LAS __attribute__((address_space(3)))
typedef unsigned short bf16_t;
typedef short bf16x8 __attribute__((ext_vector_type(8)));
typedef float f32x4 __attribute__((ext_vector_type(4)));
typedef unsigned u32x4 __attribute__((ext_vector_type(4)));
typedef unsigned u32x2 __attribute__((ext_vector_type(2)));
constexpr int BM = 256, BK = 64, HALF = 128, HTB = HALF * BK * 2  , STAGE_BYTES = 8 * HTB, NXCD = 8, WGM = 8;

__host__ __device__ __forceinline__ int lds_byte(int r, int c) { const int st = (r >> 4) * 2 + (c >> 5), rr = r & 15, cc = c & 31, ob = rr * 64 + cc * 2; return st * 1024 + (ob ^ (((ob >> 9) & 1) << 5)); }
__host__ __device__ __forceinline__ void stage_rc(int b, int& R, int& C) { const int st = b / 1024, sb = b % 1024, swz = sb ^ (((sb >> 9) & 1) << 5); R = (st >> 1) * 16 + swz / 64; C = (st & 1) * 32 + (swz % 64) / 2; }
__host__ __device__ __forceinline__ int perm32(int rho) { const int n = rho >> 4, i = rho & 15; return 8 * (i >> 2) + 4 * n + (i & 3); }

struct Unit { int pm, pn; const char* pa; const char* pb; int r0, c0, aux, S; };
struct Gemm { int lda, ldb, K; };

struct StaticOrder {
    int nM, nN, nwg, G, c;
    __host__ __device__ void init(int nM_, int nN_, int G_, int c_) { nM = nM_; nN = nN_; nwg = nM * nN; G = G_; c = c_; }
    __host__ __device__ bool next(int i, Unit& u) const {
        const long L = (long)i * G + c; if (L >= nwg) return false;
        int wgid = (int)L; { const int q = nwg / NXCD, r = nwg % NXCD, xcd = wgid % NXCD, off = wgid / NXCD; wgid = (xcd < r ? xcd * (q + 1) : r * (q + 1) + (xcd - r) * q) + off; }
        const int nig = WGM * nN, gid = wgid / nig, fm = gid * WGM, gsz = (nM - fm) < WGM ? (nM - fm) : WGM;
        u.pm = fm + ((wgid % nig) % gsz); u.pn = (wgid % nig) / gsz; return true;
    }
};

typedef float f32x2_ __attribute__((ext_vector_type(2)));
typedef __bf16 bf16x2_ __attribute__((ext_vector_type(2)));
__device__ __forceinline__ unsigned cvt_pk_bf16(float lo, float hi) { const f32x2_ v = {lo, hi}; const bf16x2_ b = __builtin_convertvector(v, bf16x2_); return __builtin_bit_cast(unsigned, b); }
__device__ __forceinline__ float bflo(unsigned w) { return __uint_as_float(w << 16); }
__device__ __forceinline__ float bfhi(unsigned w) { return __uint_as_float(w & 0xffff0000u); }
__device__ __forceinline__ float sigmoidf_(float x) { return __builtin_amdgcn_rcpf(1.0f + __builtin_amdgcn_exp2f(-1.4426950408889634f * x)); }

#define EPI_LOOP_AM _Pragma("unroll") for (int ai = 0; ai < 2; ++ai) _Pragma("unroll") for (int m = 0; m < 4; ++m)
typedef f32x4 AccT[2][2][4][2];

struct EpiStore {
    static constexpr bool PERM = true, AFTER_DRAIN = false;
    bf16_t* O; int ldc;
    __device__ __forceinline__ void operator()(AccT& acc, const Unit& u, int wr, int wc, int fr, int fq) const {
        const int row0 = u.pm * BM + wr * 64 + fr, col0 = u.pn * BM + wc * 32 + 8 * fq;
        EPI_LOOP_AM { bf16_t* rowp = O + (size_t)(row0 + ai * HALF + m * 16) * ldc + col0;
#pragma unroll
            for (int bj = 0; bj < 2; ++bj) { const f32x4 v0 = acc[ai][bj][m][0], v1 = acc[ai][bj][m][1];
                u32x4 w; w.x = cvt_pk_bf16(v0[0], v0[1]); w.y = cvt_pk_bf16(v0[2], v0[3]); w.z = cvt_pk_bf16(v1[0], v1[1]); w.w = cvt_pk_bf16(v1[2], v1[3]);
                *(u32x4*)(rowp + bj * HALF) = w; } }
    }
};

struct EpiStoreFV {
    static constexpr bool PERM = true, AFTER_DRAIN = false;
    bf16_t* FT; bf16_t* VTt;
    __device__ __forceinline__ void operator()(AccT& acc, const Unit& u, int wr, int wc, int fr, int fq) const {
        const int row0 = u.pm * BM + wr * 64 + fr, col0 = u.pn * BM + wc * 32 + 8 * fq;
        bf16_t* base; size_t s_m, s_ai, s_bj;
        if (u.pm < 2) { base = FT + (size_t)row0 * 81920 + col0; s_m = (size_t)16 * 81920; s_ai = (size_t)128 * 81920; s_bj = 128; }
        else { const int r = row0 - 512; base = VTt + ((size_t)((col0 >> 7) * 8 + (r >> 7)) * 128 + (r & 127)) * 128 + (col0 & 127); s_m = 16 * 128; s_ai = (size_t)128 * 128; s_bj = (size_t)8 * 128 * 128; }
        EPI_LOOP_AM { bf16_t* rowp = base + ai * s_ai + m * s_m;
#pragma unroll
            for (int bj = 0; bj < 2; ++bj) { const f32x4 v0 = acc[ai][bj][m][0], v1 = acc[ai][bj][m][1];
                u32x4 w; w.x = cvt_pk_bf16(v0[0], v0[1]); w.y = cvt_pk_bf16(v0[2], v0[3]); w.z = cvt_pk_bf16(v1[0], v1[1]); w.w = cvt_pk_bf16(v1[2], v1[3]);
                *(u32x4*)(rowp + bj * s_bj) = w; } }
    }
};

struct EpiDFT {
    static constexpr bool PERM = true, AFTER_DRAIN = false;
    bf16_t* AB; const bf16_t* FT; float scale;
    __device__ __forceinline__ void operator()(AccT& acc, const Unit& u, int wr, int wc, int fr, int fq) const {
        const int n0 = u.pm * BM + wr * 64 + fr, col0 = u.c0 + wc * 32 + 8 * fq; const bool sinp = u.aux != 0;
        float fn[2][8];
#pragma unroll
        for (int bj = 0; bj < 2; ++bj)
#pragma unroll
            for (int k = 0; k < 8; ++k) fn[bj][k] = sinp ? 0.f : bflo((unsigned)FT[(size_t)((col0 & 511) + bj * HALF + k) * 81920 + u.r0 + (u.S >> 1)]) * (1.0f / 1024.0f);
        EPI_LOOP_AM { const int n = n0 + ai * HALF + m * 16; const float sg = (n & 1) ? -1.f : 1.f;
            const float s1 = sinp ? -sg * scale : scale, s2 = sinp ? -s1 : s1, sn = sg * scale;
            bf16_t* p1 = AB + (size_t)(u.r0 + n) * 1024 + col0; bf16_t* p2 = AB + (size_t)(u.r0 + u.S - n) * 1024 + col0;
#pragma unroll
            for (int bj = 0; bj < 2; ++bj) { const f32x4 v0 = acc[ai][bj][m][0], v1 = acc[ai][bj][m][1];
                float r[8] = {v0[0], v0[1], v0[2], v0[3], v1[0], v1[1], v1[2], v1[3]};
#pragma unroll
                for (int k = 0; k < 8; ++k) r[k] = r[k] * s1 + sn * fn[bj][k];
                u32x4 w; w.x = cvt_pk_bf16(r[0], r[1]); w.y = cvt_pk_bf16(r[2], r[3]); w.z = cvt_pk_bf16(r[4], r[5]); w.w = cvt_pk_bf16(r[6], r[7]);
                *(u32x4*)(p1 + bj * HALF) = w;
                if (n > 0) { const float t = sinp ? -1.f : 1.f; u32x4 x; x.x = cvt_pk_bf16(r[0] * t, r[1] * t); x.y = cvt_pk_bf16(r[2] * t, r[3] * t); x.z = cvt_pk_bf16(r[4] * t, r[5] * t); x.w = cvt_pk_bf16(r[6] * t, r[7] * t);
                    *(u32x4*)(p2 + bj * HALF) = x; } } }
    }
};

typedef float f32x2v __attribute__((ext_vector_type(2)));
struct EpiGateSilu {
    static constexpr bool PERM = true, AFTER_DRAIN = false;
    bf16_t* O;
    __device__ __forceinline__ void operator()(AccT& acc, const Unit& u, int wr, int wc, int fr, int fq) const {
        const int row0 = u.pm * BM + wr * 64 + fr, col0 = u.pn * BM + wc * 32 + 8 * fq;
        bf16_t* base = O + (size_t)row0 * 1024 + col0;
        u32x4 ov[2][4][2];
        EPI_LOOP_AM {
#pragma unroll
            for (int bj = 0; bj < 2; ++bj) ov[ai][m][bj] = *(const u32x4*)(base + (ai * HALF + m * 16) * 1024 + bj * HALF); }
        EPI_LOOP_AM {
#pragma unroll
            for (int bj = 0; bj < 2; ++bj) { const u32x4 o = ov[ai][m][bj]; const unsigned owd[4] = {o.x, o.y, o.z, o.w}; unsigned rw[4];
#pragma unroll
                for (int k = 0; k < 4; ++k) { const f32x4 gq = acc[ai][bj][m][k >> 1]; const f32x2v g = (k & 1) ? (f32x2v){gq[2], gq[3]} : (f32x2v){gq[0], gq[1]};
                    const f32x2v t = g * (-1.4426950408889634f); f32x2v e; e.x = __builtin_amdgcn_exp2f(t.x); e.y = __builtin_amdgcn_exp2f(t.y); const f32x2v d = e + 1.0f;
                    f32x2v s; s.x = __builtin_amdgcn_rcpf(d.x); s.y = __builtin_amdgcn_rcpf(d.y);
                    const f32x2v ovv = {bflo(owd[k]), bfhi(owd[k])}; const f32x2v r = (ovv * g) * s; rw[k] = cvt_pk_bf16(r.x, r.y); }
                u32x4 w; w.x = rw[0]; w.y = rw[1]; w.z = rw[2]; w.w = rw[3];
                *(u32x4*)(base + (ai * HALF + m * 16) * 1024 + bj * HALF) = w; } }
    }
};

template <int MODE> struct EpiGateSig {
    static constexpr bool PERM = true, AFTER_DRAIN = false;
    bf16_t* BA; const bf16_t* BB;
    __device__ __forceinline__ void operator()(AccT& acc, const Unit& u, int wr, int wc, int fr, int fq) const {
        const int row0 = u.pm * BM + wr * 64 + fr, col0 = u.pn * BM + wc * 32 + 8 * fq;
        const size_t off0 = (size_t)row0 * 1024 + col0;
#pragma unroll
        for (int ai = 0; ai < 2; ++ai) {
            u32x4 av[4][2], bv[4][2];
#pragma unroll
            for (int m = 0; m < 4; ++m)
#pragma unroll
                for (int bj = 0; bj < 2; ++bj) { av[m][bj] = *(const u32x4*)(BA + off0 + (ai * HALF + m * 16) * 1024 + bj * HALF); if (MODE == 1) bv[m][bj] = *(const u32x4*)(BB + off0 + (ai * HALF + m * 16) * 1024 + bj * HALF); }
#pragma unroll
            for (int m = 0; m < 4; ++m)
#pragma unroll
                for (int bj = 0; bj < 2; ++bj) { const f32x4 g0 = acc[ai][bj][m][0], g1 = acc[ai][bj][m][1]; const u32x4 a = av[m][bj];
                    float r[8]; const float gg[8] = {g0[0], g0[1], g0[2], g0[3], g1[0], g1[1], g1[2], g1[3]}; const float aa[8] = {bflo(a.x), bfhi(a.x), bflo(a.y), bfhi(a.y), bflo(a.z), bfhi(a.z), bflo(a.w), bfhi(a.w)};
                    if (MODE == 0) {
#pragma unroll
                        for (int k = 0; k < 8; ++k) r[k] = aa[k] * sigmoidf_(gg[k]);
                    } else { const u32x4 b = bv[m][bj]; const float bb[8] = {bflo(b.x), bfhi(b.x), bflo(b.y), bfhi(b.y), bflo(b.z), bfhi(b.z), bflo(b.w), bfhi(b.w)};
#pragma unroll
                        for (int k = 0; k < 8; ++k) r[k] = aa[k] + bb[k] * sigmoidf_(gg[k]);
                    }
                    u32x4 w; w.x = cvt_pk_bf16(r[0], r[1]); w.y = cvt_pk_bf16(r[2], r[3]); w.z = cvt_pk_bf16(r[4], r[5]); w.w = cvt_pk_bf16(r[6], r[7]);
                    *(u32x4*)(BA + off0 + (ai * HALF + m * 16) * 1024 + bj * HALF) = w; }
        }
    }
};

typedef float f32x2 __attribute__((ext_vector_type(2)));
struct EpiChain {
    static constexpr bool PERM = true, AFTER_DRAIN = false;
    bf16_t* SA; bf16_t* SB; bf16_t* BA;
    __device__ __forceinline__ void operator()(AccT& acc, const Unit& u, int wr, int wc, int fr, int fq) const {
        int frr = fr, fqq = fq; asm volatile("" : "+v"(frr), "+v"(fqq));
        const int st = u.aux; const int loff = (wr * 64 + frr) * 256 + wc * 32 + 8 * fqq;
        if (st == 0 || st == 2) { bf16_t* T = (st == 0) ? SA : SB;
            EPI_LOOP_AM {
#pragma unroll
                for (int bj = 0; bj < 2; ++bj) { const f32x4 v0 = acc[ai][bj][m][0], v1 = acc[ai][bj][m][1];
                    u32x4 w; w.x = cvt_pk_bf16(v0[0], v0[1]); w.y = cvt_pk_bf16(v0[2], v0[3]); w.z = cvt_pk_bf16(v1[0], v1[1]); w.w = cvt_pk_bf16(v1[2], v1[3]);
                    *(u32x4*)(T + loff + (ai * HALF + m * 16) * 256 + bj * HALF) = w; } }
        } else if (st == 1) {
            EPI_LOOP_AM {
#pragma unroll
                for (int bj = 0; bj < 2; ++bj) { const int lo = loff + (ai * HALF + m * 16) * 256 + bj * HALF; const u32x4 a = *(const u32x4*)(SA + lo);
                    const unsigned aw[4] = {a.x, a.y, a.z, a.w}; unsigned ow[4];
#pragma unroll
                    for (int k = 0; k < 4; ++k) { const f32x4 gq = acc[ai][bj][m][k >> 1]; const f32x2 g = (k & 1) ? (f32x2){gq[2], gq[3]} : (f32x2){gq[0], gq[1]};
                        f32x2 e; e.x = __builtin_amdgcn_exp2f(g.x); e.y = __builtin_amdgcn_exp2f(g.y);     const f32x2 d = e + 1.0f;
                        f32x2 s; s.x = __builtin_amdgcn_rcpf(d.x); s.y = __builtin_amdgcn_rcpf(d.y);
                        const f32x2 av = {bflo(aw[k]), bfhi(aw[k])}; const f32x2 r = av * s; ow[k] = cvt_pk_bf16(r.x, r.y); }
                    u32x4 w; w.x = ow[0]; w.y = ow[1]; w.z = ow[2]; w.w = ow[3]; *(u32x4*)(SA + lo) = w; } }
        } else {
            bf16_t* gout = BA + (size_t)(u.pm * BM + wr * 64 + frr) * 1024 + u.pn * BM + wc * 32 + 8 * fqq;
            EPI_LOOP_AM {
#pragma unroll
                for (int bj = 0; bj < 2; ++bj) { const int lo = loff + (ai * HALF + m * 16) * 256 + bj * HALF; const u32x4 a = *(const u32x4*)(SA + lo), b = *(const u32x4*)(SB + lo);
                    const unsigned aw[4] = {a.x, a.y, a.z, a.w}, bw[4] = {b.x, b.y, b.z, b.w}; unsigned ow[4];
#pragma unroll
                    for (int k = 0; k < 4; ++k) { const f32x4 gq = acc[ai][bj][m][k >> 1]; const f32x2 g = (k & 1) ? (f32x2){gq[2], gq[3]} : (f32x2){gq[0], gq[1]};
                        f32x2 e; e.x = __builtin_amdgcn_exp2f(g.x); e.y = __builtin_amdgcn_exp2f(g.y);     const f32x2 d = e + 1.0f;
                        f32x2 s; s.x = __builtin_amdgcn_rcpf(d.x); s.y = __builtin_amdgcn_rcpf(d.y);
                        const f32x2 av = {bflo(aw[k]), bfhi(aw[k])}, bv = {bflo(bw[k]), bfhi(bw[k])}; const f32x2 r = bv * s + av; ow[k] = cvt_pk_bf16(r.x, r.y); }
                    u32x4 w; w.x = ow[0]; w.y = ow[1]; w.z = ow[2]; w.w = ow[3]; *(u32x4*)(gout + (size_t)(ai * HALF + m * 16) * 1024 + bj * HALF) = w; } }
        }
    }
};


__device__ __forceinline__ f32x2 gelu_pk(f32x2 v) {
    const f32x2 av = __builtin_elementwise_abs(v), d = av * 0.2316418882f + 1.0f;
    f32x2 t; t.x = __builtin_amdgcn_rcpf(d.x); t.y = __builtin_amdgcn_rcpf(d.y);
    f32x2 q = t * 0.5307027145f + (-0.7265760135f); q = q * t + 0.7107068705f; q = q * t + (-0.142248368f); q = q * t + 0.127414796f; q = q * t;
    const f32x2 s = (v * v) * (-0.72134752044f);
    f32x2 e; e.x = __builtin_amdgcn_exp2f(s.x); e.y = __builtin_amdgcn_exp2f(s.y);
    const f32x2 m = v * (q * e), r = v - m;
    f32x2 o; o.x = v.x < 0.f ? m.x : r.x; o.y = v.y < 0.f ? m.y : r.y; return o;
}
__device__ __forceinline__ float dpp_ror1(float v)  { return __builtin_bit_cast(float, __builtin_amdgcn_update_dpp(0, __builtin_bit_cast(int, v), 0x121, 0xF, 0xF, false)); }
__device__ __forceinline__ float dpp_shr1_old(float old, float v) { return __builtin_bit_cast(float, __builtin_amdgcn_update_dpp(__builtin_bit_cast(int, old), __builtin_bit_cast(int, v), 0x111, 0xF, 0xF, false)); }
__device__ __forceinline__ float dpp_shl1_old(float old, float v) { return __builtin_bit_cast(float, __builtin_amdgcn_update_dpp(__builtin_bit_cast(int, old), __builtin_bit_cast(int, v), 0x101, 0xF, 0xF, false)); }
__device__ __forceinline__ float dpp_ror15(float v) { return __builtin_bit_cast(float, __builtin_amdgcn_update_dpp(0, __builtin_bit_cast(int, v), 0x12F, 0xF, 0xF, false)); }

struct EpiConvGLU {
    static constexpr bool PERM = true, AFTER_DRAIN = false;
    bf16_t* ACT; const float* cw; const float* cb; const float* PS; PG8_LAS float* xch;
    __device__ __forceinline__ void operator()(AccT& acc, const Unit& u, int wr, int wc, int fr, int fq) const {
        const int wid = wr * 4 + wc; PG8_LAS float* my = xch + wid * 128;
        EPI_LOOP_AM { const int gr = u.c0 + ai * HALF + wr * 64 + 4 * fr + m; const int grow = gr < 0 ? 0 : (gr >= 81920 ? 81919 : gr);
            const f32x4 p = *(const f32x4*)(PS + (size_t)grow * 4); const float rr = __builtin_amdgcn_rsqf(((p[0] + p[1]) + (p[2] + p[3])) * (1.0f / 1024.0f) + 1e-6f);
#pragma unroll
            for (int bj = 0; bj < 2; ++bj)
#pragma unroll
                for (int n = 0; n < 2; ++n) acc[ai][bj][m][n] = acc[ai][bj][m][n] * rr; }
        if (fr == 0) {
#pragma unroll
            for (int ai = 0; ai < 2; ++ai) { *(PG8_LAS f32x4*)(my + (ai * 2 + 0) * 32 + fq * 8) = acc[ai][0][0][0]; *(PG8_LAS f32x4*)(my + (ai * 2 + 0) * 32 + fq * 8 + 4) = acc[ai][0][0][1]; } }
        if (fr == 15) {
#pragma unroll
            for (int ai = 0; ai < 2; ++ai) { *(PG8_LAS f32x4*)(my + (ai * 2 + 1) * 32 + fq * 8) = acc[ai][0][3][0]; *(PG8_LAS f32x4*)(my + (ai * 2 + 1) * 32 + fq * 8 + 4) = acc[ai][0][3][1]; } }
        asm volatile("s_waitcnt lgkmcnt(0)" ::: "memory"); __builtin_amdgcn_s_barrier(); asm volatile("" ::: "memory");
        const int ch0 = u.pn * 128 + wc * 32 + fq * 8;
        const bool anyb = ((u.c0 + 256) >> 12) != (u.c0 >> 12);
        f32x4 cwv[2][4];
#pragma unroll
        for (int n = 0; n < 2; ++n) { cwv[n][0] = *(const f32x4*)(cw + ch0 + 4 * n); cwv[n][1] = *(const f32x4*)(cw + 2816 + ch0 + 4 * n); cwv[n][2] = *(const f32x4*)(cw + 5632 + ch0 + 4 * n); cwv[n][3] = *(const f32x4*)(cb + ch0 + 4 * n); }
#pragma unroll
        for (int ai = 0; ai < 2; ++ai) {
            const bool hasp = (wr == 1) || (ai == 1), hasn = (wr == 0) || (ai == 0);
            const PG8_LAS float* pp = xch + (wr == 1 ? (wid - 4) * 128 + (ai * 2 + 1) * 32 : (wid + 4) * 128 + (0 * 2 + 1) * 32) + fq * 8;
            const PG8_LAS float* pn_ = xch + (wr == 0 ? (wid + 4) * 128 + (ai * 2 + 0) * 32 : (wid - 4) * 128 + (1 * 2 + 0) * 32) + fq * 8;
            f32x4 upE[2], dnE[2];
#pragma unroll
            for (int n = 0; n < 2; ++n) { f32x4 pv = (f32x4){0.f, 0.f, 0.f, 0.f}, nv = (f32x4){0.f, 0.f, 0.f, 0.f}; if (hasp) pv = *(const PG8_LAS f32x4*)(pp + 4 * n); if (hasn) nv = *(const PG8_LAS f32x4*)(pn_ + 4 * n);
#pragma unroll
                for (int j = 0; j < 4; ++j) { upE[n][j] = dpp_shr1_old(pv[j], acc[ai][0][3][n][j]); dnE[n][j] = dpp_shl1_old(nv[j], acc[ai][0][0][n][j]); } }
#pragma unroll
            for (int m = 0; m < 4; ++m) {
                const int r = ai * HALF + wr * 64 + 4 * fr + m, gr = u.c0 + r; const int S = gr < 16384 ? 4096 : 8192, pos = gr & (S - 1);
                u32x4 w4;
#pragma unroll
                for (int n = 0; n < 2; ++n) {
                    f32x4 up = (m == 0) ? upE[n] : acc[ai][0][m > 0 ? m - 1 : 0][n], dn = (m == 3) ? dnE[n] : acc[ai][0][m < 3 ? m + 1 : 3][n];
                    if (anyb) { if (pos == 0) up = (f32x4){0.f, 0.f, 0.f, 0.f}; if (pos == S - 1) dn = (f32x4){0.f, 0.f, 0.f, 0.f}; }
                    const f32x4 x = cwv[n][0] * up + cwv[n][1] * acc[ai][0][m][n] + cwv[n][2] * dn + cwv[n][3], vv = acc[ai][1][m][n];
                    const f32x2 ga = gelu_pk((f32x2){x[0], x[1]}), gb = gelu_pk((f32x2){x[2], x[3]});
                    const unsigned lo = cvt_pk_bf16(ga.x * vv[0], ga.y * vv[1]), hi = cvt_pk_bf16(gb.x * vv[2], gb.y * vv[3]);
                    if (n == 0) { w4.x = lo; w4.y = hi; } else { w4.z = lo; w4.w = hi; }
                }
                if (r >= 1 && r <= 254 && gr < 81920) __builtin_nontemporal_store(w4, (u32x4*)(ACT + (size_t)gr * 2816 + ch0));
            }
        }
    }
};

template <bool BASE_BF16> struct EpiResBf {
    static constexpr bool PERM = true, AFTER_DRAIN = false;
    const void* base; bf16_t* Y; float* PS; int grow0; PG8_LAS float* xs;
    __device__ __forceinline__ void operator()(AccT& acc, const Unit& u, int wr, int wc, int fr, int fq) const {
        const int row0 = u.pm * BM + wr * 64 + fr, col0 = u.pn * BM + wc * 32 + 8 * fq;
        const size_t off0 = (size_t)row0 * 1024 + col0;
#pragma unroll
        for (int ai = 0; ai < 2; ++ai) {
            f32x4 bs[4][2][2];
#pragma unroll
            for (int m = 0; m < 4; ++m)
#pragma unroll
                for (int bj = 0; bj < 2; ++bj) { const size_t off = off0 + (size_t)(ai * HALF + m * 16) * 1024 + bj * HALF;
                    if (BASE_BF16) { const u32x4 w = *(const u32x4*)((const bf16_t*)base + off); bs[m][bj][0] = (f32x4){bflo(w.x), bfhi(w.x), bflo(w.y), bfhi(w.y)}; bs[m][bj][1] = (f32x4){bflo(w.z), bfhi(w.z), bflo(w.w), bfhi(w.w)}; }
                    else { bs[m][bj][0] = *(const f32x4*)((const float*)base + off); bs[m][bj][1] = *(const f32x4*)((const float*)base + off + 4); } }
#pragma unroll
            for (int m = 0; m < 4; ++m) { const size_t offy = off0 + (size_t)(ai * HALF + m * 16) * 1024 + (size_t)grow0 * 1024; f32x4 sv = (f32x4){0.f, 0.f, 0.f, 0.f};
#pragma unroll
                for (int bj = 0; bj < 2; ++bj) { const f32x4 y0 = bs[m][bj][0] + acc[ai][bj][m][0], y1 = bs[m][bj][1] + acc[ai][bj][m][1];
                    sv = sv + y0 * y0; sv = sv + y1 * y1;
                    u32x4 o; o.x = cvt_pk_bf16(y0[0], y0[1]); o.y = cvt_pk_bf16(y0[2], y0[3]); o.z = cvt_pk_bf16(y1[0], y1[1]); o.w = cvt_pk_bf16(y1[2], y1[3]); *(u32x4*)(Y + offy + bj * HALF) = o; }
                float s = (sv[0] + sv[1]) + (sv[2] + sv[3]);
                { const auto r16 = __builtin_amdgcn_permlane16_swap(__float_as_uint(s), __float_as_uint(s), false, false); s = __uint_as_float(r16[0]) + __uint_as_float(r16[1]); }
                { const auto r32 = __builtin_amdgcn_permlane32_swap(__float_as_uint(s), __float_as_uint(s), false, false); s = __uint_as_float(r32[0]) + __uint_as_float(r32[1]); }
                if (fq == 0) xs[(ai * HALF + wr * 64 + m * 16 + fr) * 4 + wc] = s; }
        }
        asm volatile("s_waitcnt lgkmcnt(0)" ::: "memory"); __builtin_amdgcn_s_barrier(); asm volatile("" ::: "memory");
        const int tid = (wr * 4 + wc) * 64 + fq * 16 + fr;
        if (tid < 256) { const f32x4 p = *(const PG8_LAS f32x4*)(xs + tid * 4); PS[(size_t)(grow0 + u.pm * BM + tid) * 4 + u.pn] = (p[0] + p[1]) + (p[2] + p[3]); }
    }
};

struct EpiRotary {
    static constexpr bool PERM = true, AFTER_DRAIN = false;
    bf16_t* QK; const float* tab;
    __device__ __forceinline__ void operator()(AccT& acc, const Unit& u, int wr, int wc, int fr, int fq) const {
        const int row0 = u.pm * BM + wr * 64 + fr; const int S = (u.pm < 64) ? 4096 : 8192; const float sc = (u.pn < 2) ? 0.125f : 1.0f;
        const int part = u.pn >> 1, hb = (u.pn & 1) * 4 + (wc >> 1), d0 = 32 * (wc & 1) + 8 * fq, p0 = 16 * (wc & 1) + 4 * fq;
        bf16_t* qbase = QK + ((((size_t)part * 640 + 2 * u.pm) * 8 + hb) * 128 + wr * 64 + fr) * 64 + d0;
        f32x4 tb[2][4][2];
        EPI_LOOP_AM { const int t = row0 + ai * HALF + m * 16, pos = t & (S - 1); const float* tp = tab + ((size_t)pos * 32 + p0) * 2; tb[ai][m][0] = *(const f32x4*)tp; tb[ai][m][1] = *(const f32x4*)(tp + 4); }
        EPI_LOOP_AM { const f32x4 t0 = tb[ai][m][0], t1 = tb[ai][m][1];
            const f32x4 cs = {t0[0], t0[2], t1[0], t1[2]}, sn = {t0[1], t0[3], t1[1], t1[3]};
#pragma unroll
            for (int bj = 0; bj < 2; ++bj) { const f32x4 x1 = acc[ai][bj][m][0], x2 = acc[ai][bj][m][1];
                const f32x4 y1 = x1 * cs - x2 * sn, y2 = x1 * sn + x2 * cs;
                u32x4 w; w.x = cvt_pk_bf16(y1[0], y1[1]); w.y = cvt_pk_bf16(y1[2], y1[3]); w.z = cvt_pk_bf16(y2[0], y2[1]); w.w = cvt_pk_bf16(y2[2], y2[3]);
                *(u32x4*)(qbase + ai * (8 * 128 * 64) + m * (16 * 64) + bj * (2 * 128 * 64)) = w; } }
    }
};

template <class E> struct ARowPerm { static constexpr bool value = false; };
template <> struct ARowPerm<EpiConvGLU> { static constexpr bool value = true; };
template <class Epi, class Sched, bool ALIGN_EPI = false, bool SP2 = false>
__device__ __forceinline__ void gemm_phase(PG8_LAS unsigned char* lds, const Gemm g, const Sched& S, const Epi& E) {
    const int tid = threadIdx.x, wid = __builtin_amdgcn_readfirstlane(tid >> 6), lane = tid & 63, wr = wid >> 2, wc = wid & 3, fr = lane & 15, fq = lane >> 4;
    const int K = g.K, nt = K / BK;
    unsigned voffA[2], voffB[2];
#pragma unroll
    for (int i = 0; i < 2; ++i) { int R, C; stage_rc(tid * 16 + i * 8192, R, C); const int Rb = Epi::PERM ? ((R & ~31) + perm32(R & 31)) : R;
        const int Ra = ARowPerm<Epi>::value ? ((R & ~63) + 4 * (R & 15) + ((R >> 4) & 3)) : R;
        voffA[i] = (unsigned)(Ra * g.lda + C) * 2u; voffB[i] = (unsigned)(Rb * g.ldb + C) * 2u; }
    const size_t kstep = (size_t)(BK * 2);
    const size_t hsA = (size_t)HALF * g.lda * 2, hsB = (size_t)HALF * g.ldb * 2;
    const unsigned ldsw = (unsigned)wid * 1024u;
    const int aoff = lds_byte(wr * 64 + fr, fq * 8), boff = lds_byte(wc * 32 + fr, fq * 8);
#define PG8_SA(b, h) (((b) * 2 + (h)) * HTB)
#define PG8_SB(b, h) ((4 + (b) * 2 + (h)) * HTB)
#define PG8_STAGE(bufoff, gbase, voff) do { _Pragma("unroll") for (int _i = 0; _i < 2; ++_i) \
        __builtin_amdgcn_global_load_lds((const unsigned*)((const char*)(gbase) + (voff)[_i]), (PG8_LAS unsigned*)(lds + (bufoff) + ldsw + _i * 8192), 16, 0, 0); } while (0)
#define PG8_LDA(dst, b, h) do { _Pragma("unroll") for (int m = 0; m < 4; ++m) _Pragma("unroll") for (int k = 0; k < 2; ++k) dst[m][k] = *(const PG8_LAS bf16x8*)(lds + PG8_SA(b, h) + aoff + m * 2048 + k * 1024); } while (0)
#define PG8_LDB(dst, b, h) do { _Pragma("unroll") for (int n = 0; n < 2; ++n) _Pragma("unroll") for (int k = 0; k < 2; ++k) dst[n][k] = *(const PG8_LAS bf16x8*)(lds + PG8_SB(b, h) + boff + n * 2048 + k * 1024); } while (0)
#define PG8_MMA(ai, bj, At, Bt) do { __builtin_amdgcn_s_setprio(1); _Pragma("unroll") for (int m = 0; m < 4; ++m) _Pragma("unroll") for (int n = 0; n < 2; ++n) _Pragma("unroll") for (int k = 0; k < 2; ++k) \
        acc[ai][bj][m][n] = __builtin_amdgcn_mfma_f32_16x16x32_bf16(Bt[n][k], At[m][k], acc[ai][bj][m][n], 0, 0, 0); __builtin_amdgcn_s_setprio(0); } while (0)
#define PG8_WAIT_V(n) asm volatile("s_waitcnt vmcnt(" #n ")" ::: "memory")
#define PG8_WAIT_L(n) asm volatile("s_waitcnt lgkmcnt(" #n ")" ::: "memory")
#define PG8_BAR __builtin_amdgcn_s_barrier()
#define PG8_SCHED __builtin_amdgcn_sched_barrier(0)
    Unit cur, nxt; int ui = 0;
    if (!S.next(0, cur)) return;
    f32x4 acc[2][2][4][2];
#pragma unroll
    for (int a = 0; a < 2; ++a)
#pragma unroll
        for (int b = 0; b < 2; ++b)
#pragma unroll
            for (int m = 0; m < 4; ++m)
#pragma unroll
                for (int n = 0; n < 2; ++n) acc[a][b][m][n] = (f32x4){0.f, 0.f, 0.f, 0.f};
    bf16x8 At[4][2], B0[2][2], B1[2][2];
    const char* cA = cur.pa; const char* cB = cur.pb;

    if constexpr (SP2) {
        PG8_STAGE(PG8_SB(0, 0), cB, voffB); PG8_STAGE(PG8_SB(0, 1), cB + hsB, voffB); PG8_STAGE(PG8_SA(0, 0), cA, voffA); PG8_STAGE(PG8_SA(0, 1), cA + hsA, voffA);
        if (wr == 1) PG8_BAR;
        PG8_WAIT_V(2); PG8_BAR;
        PG8_STAGE(PG8_SB(1, 0), cB + kstep, voffB); PG8_STAGE(PG8_SA(1, 0), cA + kstep, voffA); PG8_STAGE(PG8_SB(1, 1), cB + hsB + kstep, voffB);
        PG8_WAIT_V(6); PG8_BAR;
    } else {
        PG8_STAGE(PG8_SB(0, 0), cB, voffB); PG8_STAGE(PG8_SA(0, 0), cA, voffA); PG8_STAGE(PG8_SB(0, 1), cB + hsB, voffB); PG8_STAGE(PG8_SA(0, 1), cA + hsA, voffA);
        if (wr == 1) PG8_BAR;
        PG8_WAIT_V(4); PG8_BAR;
        PG8_STAGE(PG8_SB(1, 0), cB + kstep, voffB); PG8_STAGE(PG8_SA(1, 0), cA + kstep, voffA); PG8_STAGE(PG8_SB(1, 1), cB + hsB + kstep, voffB);
        PG8_WAIT_V(6); PG8_BAR;
    }
    for (;;) {
        const bool has_next = S.next(ui + 1, nxt);
        const char* nA = has_next ? nxt.pa : cA; const char* nB = has_next ? nxt.pb : cB;
        for (int t = 0; t < nt; t += 2) {
            const bool last = (t == nt - 2);
            const char* a1 = cA + (size_t)(t + 1) * kstep;
            const char* a2 = last ? nA : cA + (size_t)(t + 2) * kstep; const char* b2 = last ? nB : cB + (size_t)(t + 2) * kstep;
            const char* a3 = a2 + kstep; const char* b3 = b2 + kstep;

            if constexpr (SP2) {
            PG8_LDB(B0, 0, 0); PG8_LDB(B1, 0, 1); PG8_SCHED; PG8_LDA(At, 0, 0); PG8_STAGE(PG8_SA(1, 1), a1 + hsA, voffA);
            PG8_WAIT_V(8); PG8_WAIT_L(0); PG8_BAR; PG8_MMA(0, 0, At, B0); PG8_MMA(0, 1, At, B1); PG8_BAR; PG8_SCHED;
            PG8_LDA(At, 0, 1); PG8_STAGE(PG8_SB(0, 0), b2, voffB); PG8_STAGE(PG8_SB(0, 1), b2 + hsB, voffB); PG8_STAGE(PG8_SA(0, 0), a2, voffA);
            PG8_WAIT_V(8); PG8_WAIT_L(0); PG8_BAR; PG8_MMA(1, 0, At, B0); PG8_MMA(1, 1, At, B1); PG8_BAR; PG8_SCHED;
            PG8_LDB(B0, 1, 0); PG8_LDB(B1, 1, 1); PG8_SCHED; PG8_LDA(At, 1, 0); PG8_STAGE(PG8_SA(0, 1), a2 + hsA, voffA);
            PG8_WAIT_V(8); PG8_WAIT_L(0); PG8_BAR; PG8_MMA(0, 0, At, B0); PG8_MMA(0, 1, At, B1); PG8_BAR; PG8_SCHED;
            PG8_LDA(At, 1, 1); PG8_STAGE(PG8_SB(1, 0), b3, voffB); PG8_STAGE(PG8_SB(1, 1), b3 + hsB, voffB); PG8_STAGE(PG8_SA(1, 0), a3, voffA);
            PG8_WAIT_V(8); PG8_WAIT_L(0); PG8_BAR; PG8_MMA(1, 0, At, B0); PG8_MMA(1, 1, At, B1); PG8_BAR; PG8_SCHED;
            } else {
            PG8_LDB(B0, 0, 0); PG8_SCHED; PG8_LDA(At, 0, 0); PG8_STAGE(PG8_SA(1, 1), a1 + hsA, voffA);
            PG8_WAIT_L(8); PG8_BAR; PG8_WAIT_L(0); PG8_MMA(0, 0, At, B0); PG8_BAR; PG8_SCHED;
            PG8_LDB(B1, 0, 1); PG8_STAGE(PG8_SB(0, 0), b2, voffB);
            PG8_BAR; PG8_WAIT_L(0); PG8_MMA(0, 1, At, B1); PG8_BAR;
            PG8_LDA(At, 0, 1); PG8_STAGE(PG8_SA(0, 0), a2, voffA);
            PG8_BAR; PG8_WAIT_L(0); PG8_MMA(1, 0, At, B0); PG8_BAR; PG8_SCHED;
            PG8_STAGE(PG8_SB(0, 1), b2 + hsB, voffB);
            PG8_WAIT_V(6); PG8_BAR; PG8_MMA(1, 1, At, B1); PG8_BAR;
            PG8_LDB(B0, 1, 0); PG8_SCHED; PG8_LDA(At, 1, 0); PG8_STAGE(PG8_SA(0, 1), a2 + hsA, voffA);
            PG8_WAIT_L(8); PG8_BAR; PG8_WAIT_L(0); PG8_MMA(0, 0, At, B0); PG8_BAR; PG8_SCHED;
            PG8_LDB(B1, 1, 1); PG8_STAGE(PG8_SB(1, 0), b3, voffB);
            PG8_BAR; PG8_WAIT_L(0); PG8_MMA(0, 1, At, B1); PG8_BAR;
            PG8_LDA(At, 1, 1); PG8_STAGE(PG8_SA(1, 0), a3, voffA);
            PG8_BAR; PG8_WAIT_L(0); PG8_MMA(1, 0, At, B0); PG8_BAR; PG8_SCHED;
            PG8_STAGE(PG8_SB(1, 1), b3 + hsB, voffB);
            PG8_WAIT_V(6); PG8_BAR; PG8_MMA(1, 1, At, B1); PG8_BAR;
            }
        }
        if constexpr (ALIGN_EPI) { if (wr == 0) PG8_BAR; }
        if constexpr (!Epi::AFTER_DRAIN) { E(acc, cur, wr, wc, fr, fq); }
        if (!has_next) break;
#pragma unroll
        for (int a = 0; a < 2; ++a)
#pragma unroll
            for (int b = 0; b < 2; ++b)
#pragma unroll
                for (int m = 0; m < 4; ++m)
#pragma unroll
                    for (int n = 0; n < 2; ++n) acc[a][b][m][n] = (f32x4){0.f, 0.f, 0.f, 0.f};
        cur = nxt; cA = nA; cB = nB; ++ui;
        if constexpr (ALIGN_EPI) { if (wr == 1) PG8_BAR; }
    }
    PG8_WAIT_V(0);
    if constexpr (!ALIGN_EPI) { if (wr == 0) PG8_BAR; }
    PG8_BAR;
    if constexpr (Epi::AFTER_DRAIN) { E.fused(acc, cur, wr, wc, fr, fq, lds, wid, lane); }
#undef PG8_SA
#undef PG8_SB
#undef PG8_STAGE
#undef PG8_LDA
#undef PG8_LDB
#undef PG8_MMA
#undef PG8_WAIT_V
#undef PG8_WAIT_L
#undef PG8_BAR
#undef PG8_SCHED
}
}

constexpr int D = 1024, NTOK_P = 4 * 4096, NTOK_S = 8 * 8192, NTOK = NTOK_P + NTOK_S;
constexpr int SP = 4096, SS = 8192, FF = 2816, NCHUNK = NTOK / 128, NRU = NCHUNK * 8;
constexpr int HALF_TOK = NTOK / 2;
constexpr float NORM_EPS = 1e-6f, GN_EPS = 1e-5f;
constexpr size_t MiB = 1u << 20;
constexpr size_t WS_WQK = 1 * MiB, WS_WFV = 3 * MiB, WS_WGRET = 6 * MiB, WS_WGA = 8 * MiB, WS_WGB = 10 * MiB, WS_W4 = 12 * MiB, WS_WRET = 14 * MiB, WS_WOUT = 16 * MiB,
                 WS_WUP = 18 * MiB, WS_WDOWN = 29 * MiB, WS_TAB = 36 * MiB, WS_LG = 38 * MiB, WS_PS1 = 40 * MiB, WS_PS2 = 42 * MiB;
constexpr size_t WS_XN = 48 * MiB, WS_FV = 208 * MiB, WS_QK = 448 * MiB, WS_O = 608 * MiB, WS_DM = 768 * MiB, WS_SCR = 896 * MiB, WS_END = 960 * MiB;
constexpr size_t WS_BA = WS_FV, WS_BB = WS_QK;
constexpr size_t WS_ACT = 208 * MiB, WS_X2B = 648 * MiB;
constexpr size_t DO_AB = 0, DO_LS = 160 * MiB;
constexpr int LDS_BYTES = 147456;

#define LAS __attribute__((address_space(3)))
typedef unsigned short bf16;
typedef unsigned v4u __attribute__((ext_vector_type(4)));
typedef unsigned v2u __attribute__((ext_vector_type(2)));
typedef float f32x4 __attribute__((ext_vector_type(4)));
typedef short bf16x8 __attribute__((ext_vector_type(8)));
using pg8::cvt_pk_bf16; using pg8::bflo; using pg8::bfhi;
__device__ __forceinline__ float wave_sum(float v) {
#pragma unroll
    for (int o = 1; o < 64; o <<= 1) v += __shfl_xor(v, o);
    return v;
}
__device__ __forceinline__ float exp2_(float x) { return __builtin_amdgcn_exp2f(x); }

#define XB_TMO      128
#define XB_XCNT(j)  (256  + 64 * (j))
#define XB_XSUB(j)  (1280 + 64 * (j))
#define XB_XGEN(j)  (2304 + 64 * (j))
#define XB_TOP      3328
#define XB_TOPGEN   3392
#define XCD_BAR_WORDS 3456
#define XB_SPIN_CAP (1u << 18)

__device__ __forceinline__ unsigned xb_ld(unsigned* p)              { return __hip_atomic_load(p, __ATOMIC_RELAXED, __HIP_MEMORY_SCOPE_AGENT); }
__device__ __forceinline__ unsigned xb_add(unsigned* p, unsigned v) { return __hip_atomic_fetch_add(p, v, __ATOMIC_RELAXED, __HIP_MEMORY_SCOPE_AGENT); }
__device__ __forceinline__ unsigned xb_xcc_id() { return (unsigned)__builtin_amdgcn_s_getreg((3 << 11) | 20) & 0xFu; }
#define XB_SPIN(cond, bar) do { unsigned _sp = 0; while (cond) { __builtin_amdgcn_s_sleep(1); \
    if ((++_sp & 255u) == 0u) { if (xb_ld(&(bar)[XB_TMO])) break; if (_sp > XB_SPIN_CAP) { atomicAdd(&(bar)[XB_TMO], 1u); break; } } } } while (0)

struct XcdBarrier {
    unsigned* bar; unsigned x;
    volatile LAS unsigned* st;
};

__device__ __forceinline__ XcdBarrier xcd_barrier_post(unsigned* bar, volatile LAS unsigned* st) {
    XcdBarrier b; b.bar = bar; b.x = xb_xcc_id(); b.st = st;
    if (threadIdx.x == 0) (void)xb_add(&bar[XB_XCNT(b.x)], 1u);
    return b;
}
__device__ __forceinline__ void xcd_barrier_complete(unsigned* bar, unsigned x, unsigned& nloc, unsigned& nx) {
    const unsigned G = gridDim.x * gridDim.y * gridDim.z;
    unsigned sum, cnt, mine, sp = 0u;
    for (;;) {
        sum = 0u; cnt = 0u; mine = 0u;
#pragma unroll
        for (unsigned j = 0; j < 16; ++j) { const unsigned c = xb_ld(&bar[XB_XCNT(j)]); sum += c; cnt += (c > 0u) ? 1u : 0u; mine = (j == x) ? c : mine; }
        if (sum == G) break;
        __builtin_amdgcn_s_sleep(1);
        if ((++sp & 255u) == 0u) { if (xb_ld(&bar[XB_TMO])) break; if (sp > XB_SPIN_CAP) { atomicAdd(&bar[XB_TMO], 1u); break; } }
    }
    nloc = mine > 0u ? mine : 1u; nx = cnt > 0u ? cnt : 1u;
}

__device__ __forceinline__ void xcd_barrier(const XcdBarrier& b) {
    asm volatile("s_waitcnt vmcnt(0)" ::: "memory");
    __syncthreads();
    if (threadIdx.x == 0) {
        unsigned* bar = b.bar;
        __builtin_amdgcn_s_waitcnt(0);
        unsigned nloc = b.st[0], nx = b.st[1];
        if (nloc == 0u) { xcd_barrier_complete(bar, b.x, nloc, nx); b.st[0] = nloc; b.st[1] = nx; }
        const unsigned old = xb_add(&bar[XB_XSUB(b.x)], 1u);
        const unsigned gen = old / nloc;
        if (old + 1u == (gen + 1u) * nloc) {
            __builtin_amdgcn_fence(__ATOMIC_RELEASE, "agent");
            asm volatile("s_waitcnt vmcnt(0)" ::: "memory");
            const unsigned og = xb_add(&bar[XB_TOP], 1u);
            const unsigned tg = og / nx;
            if (og + 1u == (tg + 1u) * nx) xb_add(&bar[XB_TOPGEN], 1u);
            else XB_SPIN(xb_ld(&bar[XB_TOPGEN]) == tg, bar);
            __builtin_amdgcn_fence(__ATOMIC_ACQUIRE, "agent");
            xb_add(&bar[XB_XGEN(b.x)], 1u);
            asm volatile("s_waitcnt vmcnt(0)" ::: "memory");
        } else {
            XB_SPIN(xb_ld(&bar[XB_XGEN(b.x)]) == gen, bar);
            __builtin_amdgcn_fence(__ATOMIC_ACQUIRE, "agent");
            asm volatile("s_waitcnt vmcnt(0)" ::: "memory");
        }
    }
    __syncthreads();
}

#define LBAR() do { asm volatile("s_waitcnt lgkmcnt(0)" ::: "memory"); __builtin_amdgcn_s_barrier(); asm volatile("" ::: "memory"); } while (0)
struct Ctx { LAS unsigned char* lds; int tid, lane, wave, gw, NGW, gtid, NT; };

template <int MODE> __device__ __forceinline__ int rowmap(int n) {
    if (MODE == 1) { const int d = n & 63, p = d & 31; return (n & ~63) | ((p >> 2) << 3) | ((d >> 5) << 2) | (p & 3); }
    if (MODE == 2) { return n < FF ? 256 * (n / 128) + (n % 128) : 256 * ((n - FF) / 128) + 128 + ((n - FF) % 128); }
    return n;
}
template <int MODE> __device__ __forceinline__ void transpose_mat(const Ctx& C, const float* W, int Ksrc, int ldw, int col0, int ncols, bf16* WT, const float* kscale = nullptr, float sscale = 1.0f) {
    LAS float* scr = (LAS float*)(C.lds + C.wave * 16384);
    const int nblk = ncols / 32, nitems = (Ksrc / 64) * nblk, lane = C.lane;
    for (int it = C.gw; it < nitems; it += C.NGW) {
        const int kb = it / nblk, nb = it % nblk, k0 = 64 * kb, n0 = 32 * nb;
#pragma unroll 8
        for (int i = 0; i < 32; ++i) { const int kk = 2 * i + (lane >> 5); scr[kk * 33 + (lane & 31)] = W[(size_t)(k0 + kk) * ldw + col0 + n0 + (lane & 31)] * (kscale ? kscale[k0 + kk] * sscale : sscale); }
        asm volatile("s_waitcnt lgkmcnt(0)" ::: "memory");
        const int c = lane & 7;
#pragma unroll
        for (int j = 0; j < 4; ++j) { const int n = (lane >> 3) + 8 * j; const LAS float* s = scr + (8 * c) * 33 + n;
            v4u o; o.x = cvt_pk_bf16(s[0 * 33], s[1 * 33]); o.y = cvt_pk_bf16(s[2 * 33], s[3 * 33]); o.z = cvt_pk_bf16(s[4 * 33], s[5 * 33]); o.w = cvt_pk_bf16(s[6 * 33], s[7 * 33]);
            *(v4u*)(WT + (size_t)rowmap<MODE>(n0 + n) * Ksrc + k0 + 8 * c) = o; }
        asm volatile("s_waitcnt lgkmcnt(0)" ::: "memory");
    }
}
__device__ __forceinline__ void rms_row_to_bf16(int lane, const float* xrow, const float* g, bf16* orow) {
    const f32x4* xr = (const f32x4*)xrow + lane; const f32x4* gr = (const f32x4*)g + lane;
    f32x4 v[4]; float s = 0.f;
#pragma unroll
    for (int j = 0; j < 4; ++j) { v[j] = xr[64 * j]; s += (v[j].x * v[j].x + v[j].y * v[j].y) + (v[j].z * v[j].z + v[j].w * v[j].w); }
    const float r = 1.0f / sqrtf(wave_sum(s) * (1.f / D) + NORM_EPS);
    v2u* o8 = (v2u*)orow + lane;
#pragma unroll
    for (int j = 0; j < 4; ++j) { const f32x4 gg = gr[64 * j]; v2u w; w.x = cvt_pk_bf16(v[j].x * r * gg.x, v[j].y * r * gg.y); w.y = cvt_pk_bf16(v[j].z * r * gg.z, v[j].w * r * gg.w); o8[64 * j] = w; }
}
__device__ __forceinline__ void rms_row2_to_bf16(int lane, const float* xa, const float* xb, const float* g, bf16* oa, bf16* ob) {
    const f32x4* pa = (const f32x4*)xa + lane; const f32x4* pb = (const f32x4*)xb + lane; const f32x4* gr = (const f32x4*)g + lane;
    f32x4 va[4], vb[4]; float sa = 0.f, sb = 0.f;
#pragma unroll
    for (int j = 0; j < 4; ++j) { va[j] = pa[64 * j]; vb[j] = pb[64 * j]; }
#pragma unroll
    for (int j = 0; j < 4; ++j) { sa += (va[j].x * va[j].x + va[j].y * va[j].y) + (va[j].z * va[j].z + va[j].w * va[j].w); sb += (vb[j].x * vb[j].x + vb[j].y * vb[j].y) + (vb[j].z * vb[j].z + vb[j].w * vb[j].w); }
    const float ra = 1.0f / sqrtf(wave_sum(sa) * (1.f / D) + NORM_EPS), rb = 1.0f / sqrtf(wave_sum(sb) * (1.f / D) + NORM_EPS);
    v2u* o8a = (v2u*)oa + lane; v2u* o8b = (v2u*)ob + lane;
#pragma unroll
    for (int j = 0; j < 4; ++j) { const f32x4 gg = gr[64 * j]; v2u w; w.x = cvt_pk_bf16(va[j].x * ra * gg.x, va[j].y * ra * gg.y); w.y = cvt_pk_bf16(va[j].z * ra * gg.z, va[j].w * ra * gg.w); o8a[64 * j] = w;
        v2u z; z.x = cvt_pk_bf16(vb[j].x * rb * gg.x, vb[j].y * rb * gg.y); z.y = cvt_pk_bf16(vb[j].z * rb * gg.z, vb[j].w * rb * gg.w); o8b[64 * j] = z; }
}
__device__ __forceinline__ void rms_row_f32(int lane, float* xrow, const float* g) {
    f32x4* xr = (f32x4*)xrow + lane; const f32x4* gr = (const f32x4*)g + lane;
    f32x4 v[4]; float s = 0.f;
#pragma unroll
    for (int j = 0; j < 4; ++j) { v[j] = xr[64 * j]; s += (v[j].x * v[j].x + v[j].y * v[j].y) + (v[j].z * v[j].z + v[j].w * v[j].w); }
    const float r = 1.0f / sqrtf(wave_sum(s) * (1.f / D) + NORM_EPS);
#pragma unroll
    for (int j = 0; j < 4; ++j) { const f32x4 gg = gr[64 * j]; xr[64 * j] = v[j] * r * gg; }
}

__device__ __forceinline__ void fold_w4(const Ctx& C, const float* Wp, bf16* W4T) {
    LAS float* tw = (LAS float*)(C.lds + 131072);
    if (C.tid < 128) { const float x = (float)C.tid * (1.0f / 128.0f); tw[C.tid] = __builtin_amdgcn_cosf(x); tw[128 + C.tid] = -__builtin_amdgcn_sinf(x); }
    __syncthreads();
    for (int item = C.gtid; item < 1024 * 128; item += C.NT) {
        const int o = item & 1023, rest = item >> 10, g = rest >> 5, part = (rest >> 4) & 1, c0 = (rest & 15) * 8;
        const float* wp = Wp + (size_t)(g * 128) * 1024 + o; const LAS float* tb = tw + part * 128; float s[8]; int idx[8];
#pragma unroll
        for (int i = 0; i < 8; ++i) { s[i] = 0.f; idx[i] = 0; }
#pragma unroll 16
        for (int c2 = 0; c2 < 128; ++c2) { const float w = wp[(size_t)c2 * 1024];
#pragma unroll
            for (int i = 0; i < 8; ++i) { s[i] += tb[idx[i]] * w; idx[i] = (idx[i] + c0 + i) & 127; } }
        v4u ov; ov.x = cvt_pk_bf16(s[0], s[1]); ov.y = cvt_pk_bf16(s[2], s[3]); ov.z = cvt_pk_bf16(s[4], s[5]); ov.w = cvt_pk_bf16(s[6], s[7]);
        *(v4u*)(W4T + (size_t)o * 1024 + part * 512 + g * 128 + c0) = ov;
    }
    __syncthreads();
}
__device__ __forceinline__ void gen_dm(const Ctx& C, bf16* DM) {
    for (int idx = C.gtid; idx < 2 * 4096 * 512; idx += C.NT) {
        const int part = idx >> 21, n = (idx >> 9) & 4095, m0 = (idx & 511) * 8; float v[8];
#pragma unroll
        for (int j = 0; j < 8; ++j) { const float x = (float)((n * (m0 + j)) & 8191) * (1.0f / 8192.0f); v[j] = (part ? __builtin_amdgcn_sinf(x) : __builtin_amdgcn_cosf(x)) * (1.0f / 1024.0f); }
        v4u o; o.x = cvt_pk_bf16(v[0], v[1]); o.y = cvt_pk_bf16(v[2], v[3]); o.z = cvt_pk_bf16(v[4], v[5]); o.w = cvt_pk_bf16(v[6], v[7]);
        *(v4u*)(DM + (size_t)idx * 8) = o;
    }
}
__device__ __forceinline__ void fold_ft(const Ctx& C, bf16* FT) {
    constexpr int NCH = 512 * (NTOK / 16);
    for (int idx = C.gtid; idx < NCH; idx += C.NT) {
        const int c = idx / (NTOK / 16), q = idx % (NTOK / 16); int r0, m0, S;
        if (q < NTOK_P / 16) { S = SP; r0 = (q / (SP / 16)) * SP; m0 = (q % (SP / 16)) * 8; } else { const int q2 = q - NTOK_P / 16; S = SS; r0 = NTOK_P + (q2 / (SS / 16)) * SS; m0 = (q2 % (SS / 16)) * 8; }
        bf16* row = FT + (size_t)c * NTOK + r0;
        const v4u X = *(const v4u*)(row + m0), Z = *(const v4u*)(row + S - m0 - 8); const unsigned short p0 = (m0 > 0) ? row[S - m0] : (unsigned short)0;
        const float x[8] = {bflo(X.x), bfhi(X.x), bflo(X.y), bfhi(X.y), bflo(X.z), bfhi(X.z), bflo(X.w), bfhi(X.w)};
        const float z[8] = {bflo(Z.x), bfhi(Z.x), bflo(Z.y), bfhi(Z.y), bflo(Z.z), bfhi(Z.z), bflo(Z.w), bfhi(Z.w)};
        float xo[8], zo[8];
        const float pz = bflo((unsigned)p0);
        xo[0] = (m0 > 0) ? x[0] + pz : x[0];
#pragma unroll
        for (int t = 1; t < 8; ++t) { xo[t] = x[t] + z[8 - t]; zo[8 - t] = x[t] - z[8 - t]; }
        v4u XO; XO.x = cvt_pk_bf16(xo[0], xo[1]); XO.y = cvt_pk_bf16(xo[2], xo[3]); XO.z = cvt_pk_bf16(xo[4], xo[5]); XO.w = cvt_pk_bf16(xo[6], xo[7]);
        *(v4u*)(row + m0) = XO;
        bf16* zp = row + S - m0 - 8;
        zp[1] = (bf16)(cvt_pk_bf16(zo[1], 0.f) & 0xffffu); *(unsigned*)(zp + 2) = cvt_pk_bf16(zo[2], zo[3]); { v2u w; w.x = cvt_pk_bf16(zo[4], zo[5]); w.y = cvt_pk_bf16(zo[6], zo[7]); *(v2u*)(zp + 4) = w; }
        if (m0 > 0) row[S - m0] = (bf16)(cvt_pk_bf16(x[0] - pz, 0.f) & 0xffffu);
    }
}
__device__ __forceinline__ void gen_tab(const Ctx& C, float* tab, const float* decay_logit, float* lg2) {
    for (int idx = C.gtid; idx < 8192 * 32; idx += C.NT) {
        const int pos = idx >> 5, p = idx & 31;
        const double inv = exp(-(double)p * (9.210340371976184 / 32.0));
        double t = (double)pos * inv * 0.15915494309189535; t -= floor(t);
        const float x = (float)t; tab[2 * idx] = __builtin_amdgcn_cosf(x); tab[2 * idx + 1] = __builtin_amdgcn_sinf(x);
    }
    if (C.gtid < 16) { const float x = decay_logit[C.gtid]; const float ls = -log1pf(expf(-x)); lg2[C.gtid] = ls * 1.4426950408889634f; }
}
__device__ __forceinline__ void r1_phase(const Ctx& C, const bf16* QK, const bf16* VT, bf16* LS, const float* lg2) {
    const int tid = C.tid, w = C.wave, lane = C.lane, fr = lane & 15, fq = lane >> 4;
    LAS unsigned char* KT = C.lds;
    LAS float* LGL = (LAS float*)(C.lds + 128 * 272);
    if (tid < 16) LGL[tid] = lg2[tid];
    __syncthreads();
    int u = blockIdx.x; if (u >= NRU) return;
    const int e = 16 * w + fr; v4u kv[2]; bf16x8 va[4];
#pragma unroll
    for (int i = 0; i < 2; ++i) { const int q = tid + 512 * i; kv[i] = *(const v4u*)(QK + ((size_t)(NRU + u) * 128 + (q >> 3)) * 64 + (q & 7) * 8); }
#pragma unroll
    for (int ks = 0; ks < 4; ++ks) va[ks] = *(const bf16x8*)(VT + ((size_t)u * 128 + e) * 128 + ks * 32 + fq * 8);
    for (; u < NRU; u += gridDim.x) {
        const int h = u & 7; const float lf = LGL[h], lb = LGL[8 + h];
#pragma unroll
        for (int i = 0; i < 2; ++i) { const int q = tid + 512 * i, ap = q >> 3, dg = q & 7;
            const float sf = exp2_(lf * (float)(127 - ap)), sb = exp2_(lb * (float)ap);
            const float kf[8] = {bflo(kv[i].x), bfhi(kv[i].x), bflo(kv[i].y), bfhi(kv[i].y), bflo(kv[i].z), bfhi(kv[i].z), bflo(kv[i].w), bfhi(kv[i].w)};
#pragma unroll
            for (int j = 0; j < 8; ++j) { const int d = dg * 8 + j;
                *(LAS bf16*)(KT + d * 272 + ap * 2) = (bf16)(cvt_pk_bf16(kf[j] * sf, 0.f) & 0xffffu);
                *(LAS bf16*)(KT + (64 + d) * 272 + ap * 2) = (bf16)(cvt_pk_bf16(kf[j] * sb, 0.f) & 0xffffu); } }
        bf16x8 vc[4];
#pragma unroll
        for (int ks = 0; ks < 4; ++ks) vc[ks] = va[ks];
        LBAR();
        { const int un = u + gridDim.x, unx = un < NRU ? un : u;
#pragma unroll
          for (int i = 0; i < 2; ++i) { const int q = tid + 512 * i; kv[i] = *(const v4u*)(QK + ((size_t)(NRU + unx) * 128 + (q >> 3)) * 64 + (q & 7) * 8); }
#pragma unroll
          for (int ks = 0; ks < 4; ++ks) va[ks] = *(const bf16x8*)(VT + ((size_t)unx * 128 + e) * 128 + ks * 32 + fq * 8); }
        f32x4 acc[8];
#pragma unroll
        for (int c2 = 0; c2 < 8; c2 += 2) { bf16x8 kb[2][4];
#pragma unroll
            for (int cc = 0; cc < 2; ++cc)
#pragma unroll
                for (int ks = 0; ks < 4; ++ks) kb[cc][ks] = *(const LAS bf16x8*)(KT + (16 * (c2 + cc) + fr) * 272 + ks * 64 + fq * 16);
            __builtin_amdgcn_sched_barrier(0);
            f32x4 a0 = (f32x4){0.f, 0.f, 0.f, 0.f}, a1 = (f32x4){0.f, 0.f, 0.f, 0.f};
#pragma unroll
            for (int ks = 0; ks < 4; ++ks) { a0 = __builtin_amdgcn_mfma_f32_16x16x32_bf16(kb[0][ks], vc[ks], a0, 0, 0, 0); a1 = __builtin_amdgcn_mfma_f32_16x16x32_bf16(kb[1][ks], vc[ks], a1, 0, 0, 0); }
            acc[c2] = a0; acc[c2 + 1] = a1;
            __builtin_amdgcn_sched_barrier(0); }
        bf16* op = LS + ((size_t)u * 128 + e) * 128 + 4 * fq;
#pragma unroll
        for (int ct = 0; ct < 8; ++ct) { v2u wv; wv.x = cvt_pk_bf16(acc[ct][0], acc[ct][1]); wv.y = cvt_pk_bf16(acc[ct][2], acc[ct][3]); *(v2u*)(op + 16 * ct) = wv; }
        LBAR();
    }
}
struct ScanItem { bf16* base; int nch, ck0, dir; float dec; };
__device__ __forceinline__ ScanItem scan_item(int it, bf16* LS, const float* lg2) {
    const int ddg = it & 15, e = (it >> 4) & 127, h = (it >> 11) & 7, sq = it >> 14; ScanItem s;
    s.nch = sq < 4 ? 32 : 64; s.ck0 = sq < 4 ? sq * 32 : 128 + (sq - 4) * 64; s.dir = ddg >> 3;
    s.dec = exp2_(128.0f * lg2[s.dir * 8 + h]); s.base = LS + ((size_t)h * 128 + e) * 128 + ddg * 8; return s;
}
__device__ __forceinline__ void scan_step(const ScanItem& I, int i, const v4u ld, float (&s)[8]) {
    const int ck = I.ck0 + (I.dir ? I.nch - 1 - i : i);
    v4u o; o.x = cvt_pk_bf16(s[0], s[1]); o.y = cvt_pk_bf16(s[2], s[3]); o.z = cvt_pk_bf16(s[4], s[5]); o.w = cvt_pk_bf16(s[6], s[7]);
    *(v4u*)(I.base + (size_t)ck * 131072) = o;
    const float l[8] = {bflo(ld.x), bfhi(ld.x), bflo(ld.y), bfhi(ld.y), bflo(ld.z), bfhi(ld.z), bflo(ld.w), bfhi(ld.w)};
#pragma unroll
    for (int j = 0; j < 8; ++j) s[j] = s[j] * I.dec + l[j];
}
__device__ __forceinline__ void r2_phase(const Ctx& C, bf16* LS, const float* lg2) {
    constexpr int NIT = 12 * 8 * 128 * 16, NA = 131072;
    for (int t0 = C.gtid; t0 < NA; t0 += C.NT) {
        const bool hasB = t0 + NA < NIT;
        const ScanItem A = scan_item(t0, LS, lg2), B = scan_item(hasB ? t0 + NA : t0, LS, lg2);
        float sA[8], sB[8];
#pragma unroll
        for (int j = 0; j < 8; ++j) { sA[j] = 0.f; sB[j] = 0.f; }
        const int nmax = hasB ? (A.nch > B.nch ? A.nch : B.nch) : A.nch;
        for (int i0 = 0; i0 < nmax; i0 += 8) {
            const bool actA = i0 < A.nch, actB = hasB && i0 < B.nch;
            v4u ldA[8], ldB[8];
#pragma unroll
            for (int k = 0; k < 8; ++k) { const int i = i0 + k;
                ldA[k] = actA ? *(const v4u*)(A.base + (size_t)(A.ck0 + (A.dir ? A.nch - 1 - i : i)) * 131072) : (v4u){0u, 0u, 0u, 0u};
                ldB[k] = actB ? *(const v4u*)(B.base + (size_t)(B.ck0 + (B.dir ? B.nch - 1 - i : i)) * 131072) : (v4u){0u, 0u, 0u, 0u}; }
#pragma unroll
            for (int k = 0; k < 8; ++k) { if (actA) scan_step(A, i0 + k, ldA[k], sA); if (actB) scan_step(B, i0 + k, ldB[k], sB); }
        }
    }
}
struct R3Loads { bf16x8 qa[2], kb[8][2], bfr[8]; };
__device__ __forceinline__ void r3_issue_qk(R3Loads& L, const bf16* QK, int u, int w, int fr, int fq) {
#pragma unroll
    for (int ks = 0; ks < 2; ++ks) L.qa[ks] = *(const bf16x8*)(QK + ((size_t)u * 128 + 16 * w + fr) * 64 + ks * 32 + fq * 8);
#pragma unroll
    for (int ct = 0; ct < 8; ++ct)
#pragma unroll
        for (int ks = 0; ks < 2; ++ks) L.kb[ct][ks] = *(const bf16x8*)(QK + ((size_t)(NRU + u) * 128 + 16 * ct + fr) * 64 + ks * 32 + fq * 8);
}
__device__ __forceinline__ void r3_issue_b(R3Loads& L, const bf16* VT, const bf16* LS, int u, int w, int fr, int fq) {
#pragma unroll
    for (int ks = 0; ks < 4; ++ks) L.bfr[ks] = *(const bf16x8*)(VT + ((size_t)u * 128 + 16 * w + fr) * 128 + ks * 32 + fq * 8);
#pragma unroll
    for (int ks = 0; ks < 4; ++ks) L.bfr[4 + ks] = *(const bf16x8*)(LS + ((size_t)u * 128 + 16 * w + fr) * 128 + ks * 32 + fq * 8);
}
__device__ __forceinline__ void r3_phase(const Ctx& C, const bf16* QK, const bf16* VT, const bf16* LS, bf16* O, const float* lg2) {
    const int w = C.wave, lane = C.lane, fr = lane & 15, fq = lane >> 4;
    LAS unsigned char* A2 = C.lds; LAS float* RED = (LAS float*)(C.lds + 128 * 528);
    LAS float* LGL = (LAS float*)(C.lds + 128 * 528 + 8192);
    if (C.tid < 16) LGL[C.tid] = lg2[C.tid];
    __syncthreads();
    int u = blockIdx.x; if (u >= NRU) return;
    R3Loads cur; r3_issue_qk(cur, QK, u, w, fr, fq); r3_issue_b(cur, VT, LS, u, w, fr, fq);
    for (; u < NRU; u += gridDim.x) {
        const int ck = u >> 3, h = u & 7; const size_t t0 = (size_t)ck * 128; const float lf = LGL[h], lb = LGL[8 + h];
        const int a = 16 * w + fr;
#pragma unroll
        for (int ct = 0; ct < 8; ++ct) { f32x4 sc = (f32x4){0.f, 0.f, 0.f, 0.f};
#pragma unroll
            for (int ks = 0; ks < 2; ++ks) sc = __builtin_amdgcn_mfma_f32_16x16x32_bf16(cur.kb[ct][ks], cur.qa[ks], sc, 0, 0, 0);
            float p[4];
#pragma unroll
            for (int j = 0; j < 4; ++j) { const int df = a - (16 * ct + 4 * fq + j); const float dcy = df >= 0 ? exp2_(lf * (float)df) : exp2_(lb * (float)(-df)); p[j] = sc[j] * dcy; }
            v2u wv; wv.x = cvt_pk_bf16(p[0], p[1]); wv.y = cvt_pk_bf16(p[2], p[3]); *(LAS v2u*)(A2 + a * 528 + (16 * ct + 4 * fq) * 2) = wv; }
        { const float gf = exp2_(lf * (float)(a + 1)), gb = exp2_(lb * (float)(128 - a));
#pragma unroll
          for (int ks = 0; ks < 2; ++ks) { const v4u qv = __builtin_bit_cast(v4u, cur.qa[ks]);
              const float qf[8] = {bflo(qv.x), bfhi(qv.x), bflo(qv.y), bfhi(qv.y), bflo(qv.z), bfhi(qv.z), bflo(qv.w), bfhi(qv.w)};
              v4u f, b; f.x = cvt_pk_bf16(qf[0] * gf, qf[1] * gf); f.y = cvt_pk_bf16(qf[2] * gf, qf[3] * gf); f.z = cvt_pk_bf16(qf[4] * gf, qf[5] * gf); f.w = cvt_pk_bf16(qf[6] * gf, qf[7] * gf);
              b.x = cvt_pk_bf16(qf[0] * gb, qf[1] * gb); b.y = cvt_pk_bf16(qf[2] * gb, qf[3] * gb); b.z = cvt_pk_bf16(qf[4] * gb, qf[5] * gb); b.w = cvt_pk_bf16(qf[6] * gb, qf[7] * gb);
              *(LAS v4u*)(A2 + a * 528 + (128 + ks * 32 + fq * 8) * 2) = f; *(LAS v4u*)(A2 + a * 528 + (192 + ks * 32 + fq * 8) * 2) = b; } }
        LBAR();
        const int un = u + gridDim.x, unx = un < NRU ? un : u;
        r3_issue_qk(cur, QK, unx, w, fr, fq);
        f32x4 oc[8];
#pragma unroll
        for (int rt = 0; rt < 8; ++rt) { oc[rt] = (f32x4){0.f, 0.f, 0.f, 0.f};
#pragma unroll
            for (int ks = 0; ks < 8; ++ks) { const bf16x8 af = *(const LAS bf16x8*)(A2 + (16 * rt + fr) * 528 + ks * 64 + fq * 16); oc[rt] = __builtin_amdgcn_mfma_f32_16x16x32_bf16(cur.bfr[ks], af, oc[rt], 0, 0, 0); } }
        r3_issue_b(cur, VT, LS, unx, w, fr, fq);
#pragma unroll
        for (int rt = 0; rt < 8; ++rt) { float s1 = (oc[rt][0] + oc[rt][1]) + (oc[rt][2] + oc[rt][3]), s2 = (oc[rt][0] * oc[rt][0] + oc[rt][1] * oc[rt][1]) + (oc[rt][2] * oc[rt][2] + oc[rt][3] * oc[rt][3]);
            s1 += __shfl_xor(s1, 16); s1 += __shfl_xor(s1, 32); s2 += __shfl_xor(s2, 16); s2 += __shfl_xor(s2, 32);
            if (fq == 0) { RED[(16 * rt + fr) * 8 + w] = s1; RED[1024 + (16 * rt + fr) * 8 + w] = s2; } }
        LBAR();
        bf16* op = O + (t0 + fr) * 1024 + h * 128 + 16 * w + 4 * fq;
#pragma unroll
        for (int rt = 0; rt < 8; ++rt) { const LAS float* rp = RED + (16 * rt + fr) * 8;
            const f32x4 x0 = *(const LAS f32x4*)rp, x1 = *(const LAS f32x4*)(rp + 4), y0 = *(const LAS f32x4*)(rp + 1024), y1 = *(const LAS f32x4*)(rp + 1028);
            const float S1 = ((x0[0] + x0[1]) + (x0[2] + x0[3])) + ((x1[0] + x1[1]) + (x1[2] + x1[3])), S2 = ((y0[0] + y0[1]) + (y0[2] + y0[3])) + ((y1[0] + y1[1]) + (y1[2] + y1[3]));
            const float mu = S1 * (1.f / 128.f), var = fmaxf(S2 * (1.f / 128.f) - mu * mu, 0.f), rs = __builtin_amdgcn_rsqf(var + GN_EPS);
            v2u wv; wv.x = cvt_pk_bf16((oc[rt][0] - mu) * rs, (oc[rt][1] - mu) * rs); wv.y = cvt_pk_bf16((oc[rt][2] - mu) * rs, (oc[rt][3] - mu) * rs);
            *(v2u*)(op + (size_t)(16 * rt) * 1024) = wv; }
        LBAR();
    }
}
__device__ __forceinline__ void dft_nyquist(const Ctx& C, const bf16* FT, bf16* AB) {
    for (int it = C.gw; it < 12 * 512; it += C.NGW) {
        const int sq = it >> 9, c = it & 511, S = sq < 4 ? SP : SS, r0 = sq < 4 ? sq * SP : NTOK_P + (sq - 4) * SS;
        const bf16* src = FT + (size_t)c * NTOK + r0; float s = 0.f;
        for (int m0 = C.lane * 8; m0 < S / 2; m0 += 2048) { v4u v[4];
#pragma unroll
            for (int k = 0; k < 4; ++k) v[k] = *(const v4u*)(src + m0 + 512 * k);
#pragma unroll
            for (int k = 0; k < 4; ++k) s += (bflo(v[k].x) - bfhi(v[k].x)) + (bflo(v[k].y) - bfhi(v[k].y)) + (bflo(v[k].z) - bfhi(v[k].z)) + (bflo(v[k].w) - bfhi(v[k].w)); }
        s = (wave_sum(s) + bflo((unsigned)src[S / 2])) * (sq < 4 ? 0.001381067932f : 0.0009765625f);
        if (C.lane == 0) { AB[(size_t)(r0 + S / 2) * 1024 + c] = (bf16)(cvt_pk_bf16(s, 0.f) & 0xffffu); AB[(size_t)(r0 + S / 2) * 1024 + 512 + c] = 0; }
    }
}
__device__ __forceinline__ void conv_act(const Ctx& C, const bf16* H, bf16* ACT, const float* cw, const float* cb, int half) {
    for (int idx = C.gtid; idx < HALF_TOK * (FF / 8); idx += C.NT) {
        const int tl = idx / (FF / 8), ch0 = (idx % (FF / 8)) * 8, t = half * HALF_TOK + tl;
        const int S = t < NTOK_P ? SP : SS, pos = t & (S - 1), hc = 256 * (ch0 >> 7) + (ch0 & 127);
        const bf16* hr = H + (size_t)tl * (2 * FF) + hc;
        const v4u g1 = *(const v4u*)hr, vv = *(const v4u*)(hr + 128); v4u g0 = (v4u){0u, 0u, 0u, 0u}, g2 = (v4u){0u, 0u, 0u, 0u};
        if (pos > 0) g0 = *(const v4u*)(hr - 2 * FF);
        if (pos < S - 1) g2 = *(const v4u*)(hr + 2 * FF);
        const float a0[8] = {bflo(g0.x), bfhi(g0.x), bflo(g0.y), bfhi(g0.y), bflo(g0.z), bfhi(g0.z), bflo(g0.w), bfhi(g0.w)};
        const float a1[8] = {bflo(g1.x), bfhi(g1.x), bflo(g1.y), bfhi(g1.y), bflo(g1.z), bfhi(g1.z), bflo(g1.w), bfhi(g1.w)};
        const float a2[8] = {bflo(g2.x), bfhi(g2.x), bflo(g2.y), bfhi(g2.y), bflo(g2.z), bfhi(g2.z), bflo(g2.w), bfhi(g2.w)};
        const float av[8] = {bflo(vv.x), bfhi(vv.x), bflo(vv.y), bfhi(vv.y), bflo(vv.z), bfhi(vv.z), bflo(vv.w), bfhi(vv.w)};
        float r[8];
#pragma unroll
        for (int j = 0; j < 8; ++j) { const float x = cw[ch0 + j] * a0[j] + cw[FF + ch0 + j] * a1[j] + cw[2 * FF + ch0 + j] * a2[j] + cb[ch0 + j];
            r[j] = 0.5f * x * (1.0f + erff(x * 0.70710678118654752f)) * av[j]; }
        v4u o; o.x = cvt_pk_bf16(r[0], r[1]); o.y = cvt_pk_bf16(r[2], r[3]); o.z = cvt_pk_bf16(r[4], r[5]); o.w = cvt_pk_bf16(r[6], r[7]);
        *(v4u*)(ACT + (size_t)tl * FF + ch0) = o;
    }
}

__device__ __forceinline__ void dbg_dump(const Ctx& C, float* out, const bf16* X, const bf16* Y) {
    for (size_t j = C.gtid; j < (size_t)NTOK * D; j += C.NT) { float v = __uint_as_float((unsigned)X[j] << 16); if (Y) v += __uint_as_float((unsigned)Y[j] << 16); out[j] = v; }
}
__device__ __forceinline__ void final_rows(const Ctx& C, const bf16* X2B, const float* PS2, const float* g, float* out) {
    const int lane = C.lane; f32x4 gg[4];
#pragma unroll
    for (int k = 0; k < 2; ++k) { gg[2 * k] = *(const f32x4*)(g + k * 512 + lane * 8); gg[2 * k + 1] = *(const f32x4*)(g + k * 512 + lane * 8 + 4); }
    for (int m = C.gw; m < NTOK; m += 2 * C.NGW) {
        const int m2 = m + C.NGW; const bool has2 = m2 < NTOK; const int mb = has2 ? m2 : m;
        const v4u a0 = *(const v4u*)(X2B + (size_t)m * D + lane * 8), a1 = *(const v4u*)(X2B + (size_t)m * D + 512 + lane * 8);
        const v4u b0 = *(const v4u*)(X2B + (size_t)mb * D + lane * 8), b1 = *(const v4u*)(X2B + (size_t)mb * D + 512 + lane * 8);
        const f32x4 pa = *(const f32x4*)(PS2 + (size_t)m * 4), pb = *(const f32x4*)(PS2 + (size_t)mb * 4);
        const float ra = 1.0f / sqrtf(((pa[0] + pa[1]) + (pa[2] + pa[3])) * (1.f / D) + NORM_EPS), rb = 1.0f / sqrtf(((pb[0] + pb[1]) + (pb[2] + pb[3])) * (1.f / D) + NORM_EPS);
        float* oa = out + (size_t)m * D + lane * 8; float* ob = out + (size_t)mb * D + lane * 8;
        *(f32x4*)(oa) = (f32x4){bflo(a0.x), bfhi(a0.x), bflo(a0.y), bfhi(a0.y)} * ra * gg[0]; *(f32x4*)(oa + 4) = (f32x4){bflo(a0.z), bfhi(a0.z), bflo(a0.w), bfhi(a0.w)} * ra * gg[1];
        *(f32x4*)(oa + 512) = (f32x4){bflo(a1.x), bfhi(a1.x), bflo(a1.y), bfhi(a1.y)} * ra * gg[2]; *(f32x4*)(oa + 516) = (f32x4){bflo(a1.z), bfhi(a1.z), bflo(a1.w), bfhi(a1.w)} * ra * gg[3];
        if (has2) {
        *(f32x4*)(ob) = (f32x4){bflo(b0.x), bfhi(b0.x), bflo(b0.y), bfhi(b0.y)} * rb * gg[0]; *(f32x4*)(ob + 4) = (f32x4){bflo(b0.z), bfhi(b0.z), bflo(b0.w), bfhi(b0.w)} * rb * gg[1];
        *(f32x4*)(ob + 512) = (f32x4){bflo(b1.x), bfhi(b1.x), bflo(b1.y), bfhi(b1.y)} * rb * gg[2]; *(f32x4*)(ob + 516) = (f32x4){bflo(b1.z), bfhi(b1.z), bflo(b1.w), bfhi(b1.w)} * rb * gg[3]; }
    }
}
struct SchedG {
    pg8::StaticOrder so; const char* A; const char* B; size_t tsa, tsb; int pm_off;
    __device__ __forceinline__ bool next(int i, pg8::Unit& u) const { if (!so.next(i, u)) return false; u.pa = A + (size_t)u.pm * tsa; u.pb = B + (size_t)u.pn * tsb; u.pm += pm_off; u.r0 = 0; u.c0 = 0; u.aux = 0; u.S = 0; return true; }
};
struct SchedDFT {
    pg8::StaticOrder so; const char* DM; const char* FT; int ntile, S, tok0; size_t lda_b;
    __device__ __forceinline__ bool next(int i, pg8::Unit& u) const {
        if (!so.next(i, u)) return false;
        const int part = u.pm / ntile, nt = u.pm % ntile, sq = u.pn >> 1, hf = u.pn & 1;
        u.pa = DM + (size_t)part * ((size_t)4096 * 4096 * 2) + (size_t)nt * 256 * lda_b;
        u.pb = FT + ((size_t)(hf * 256) * NTOK + (size_t)(tok0 + sq * S + part * (S >> 1))) * 2;
        u.pm = nt; u.r0 = tok0 + sq * S; u.c0 = part * 512 + hf * 256; u.aux = part; u.S = S; return true;
    }
};

struct SchedChain {
    pg8::StaticOrder so; const char* AB; const char* ws;
    __device__ __forceinline__ bool next(int i, pg8::Unit& u) const {
        const int st = i & 3; if (!so.next(i >> 2, u)) return false;
        const size_t offA = (st == 2) ? WS_O : WS_XN;
        const size_t offB = WS_W4 - (size_t)(st == 1) * (4 * MiB) + (size_t)(st == 2) * (2 * MiB) - (size_t)(st == 3) * (2 * MiB);
        const char* A = ws + offA; if (st == 0) A = AB;
        u.pa = A + (size_t)u.pm * ((size_t)256 * 1024 * 2); u.pb = ws + offB + (size_t)u.pn * ((size_t)256 * 1024 * 2); u.aux = st; u.r0 = 0; u.c0 = 0; u.S = 0; return true;
    }
};
struct SchedUp {
    pg8::StaticOrder so; const char* XN2; const char* W;
    __device__ __forceinline__ bool next(int i, pg8::Unit& u) const {
        if (!so.next(i, u)) return false;
        u.c0 = 254 * u.pm - 1; u.r0 = 0; u.S = 0; u.aux = 0;
        u.pa = XN2 + ((long)u.c0) * 2048; u.pb = W + (size_t)u.pn * ((size_t)256 * 1024 * 2); return true;
    }
};

constexpr int NPHASE = 11;
struct Args { const float* in[14]; float* out; unsigned char* ws; int ph_lo, ph_hi; };
__global__ void __launch_bounds__(512, 2) fwd_kernel(Args args) {
    extern __shared__ __attribute__((aligned(16))) unsigned char lds_raw[];
    Ctx C; C.lds = (LAS unsigned char*)lds_raw; C.tid = threadIdx.x; C.lane = C.tid & 63; C.wave = __builtin_amdgcn_readfirstlane(C.tid >> 6);
    C.gw = blockIdx.x * 8 + C.wave; C.NGW = gridDim.x * 8; C.gtid = blockIdx.x * 512 + C.tid; C.NT = gridDim.x * 512;
    const int G = gridDim.x, bx = blockIdx.x;
    unsigned char* ws = args.ws;
    const float* x_p = args.in[0]; const float* x_s = args.in[1]; const float* norm1_g = args.in[2]; const float* w_in = args.in[3]; const float* w_four = args.in[4];
    const float* w_ret = args.in[5]; const float* w_out = args.in[6]; const float* decay_logit = args.in[7]; const float* norm2_g = args.in[8]; const float* w_up = args.in[9];
    const float* conv_w = args.in[10]; const float* conv_b = args.in[11]; const float* w_down = args.in[12]; const float* final_g = args.in[13];
    float* out = args.out;
    bf16* WQK = (bf16*)(ws + WS_WQK); bf16* WFV = (bf16*)(ws + WS_WFV); bf16* WGRET = (bf16*)(ws + WS_WGRET); bf16* WGA = (bf16*)(ws + WS_WGA); bf16* WGB = (bf16*)(ws + WS_WGB);
    bf16* W4 = (bf16*)(ws + WS_W4); bf16* WRET = (bf16*)(ws + WS_WRET); bf16* WOUT = (bf16*)(ws + WS_WOUT); bf16* WUP = (bf16*)(ws + WS_WUP); bf16* WDOWN = (bf16*)(ws + WS_WDOWN);
    float* TAB = (float*)(ws + WS_TAB); float* LG = (float*)(ws + WS_LG);
    bf16* XN = (bf16*)(ws + WS_XN); bf16* FV = (bf16*)(ws + WS_FV); bf16* QK = (bf16*)(ws + WS_QK); bf16* OB = (bf16*)(ws + WS_O); bf16* DM = (bf16*)(ws + WS_DM);
    bf16* BA = (bf16*)(ws + WS_BA); bf16* BB = (bf16*)(ws + WS_BB); bf16* ACT = (bf16*)(ws + WS_ACT); bf16* X2B = (bf16*)(ws + WS_X2B); float* PS1 = (float*)(ws + WS_PS1); float* PS2 = (float*)(ws + WS_PS2);
    bf16* AB = (bf16*)((unsigned char*)out + DO_AB);
#ifdef DBG_LS_IN_WS
    bf16* LS = (bf16*)(ws + WS_O);
#else
    bf16* LS = (bf16*)((unsigned char*)out + DO_LS);
#endif
    const bf16* VT = FV + (size_t)512 * NTOK;
    const int lo = args.ph_lo, hi = args.ph_hi;
    volatile LAS unsigned* XST = (volatile LAS unsigned*)(C.lds + LDS_BYTES - 16);
    if (C.tid < 2) XST[C.tid] = 0u;
    __syncthreads();
    XcdBarrier xbar; xbar.bar = (unsigned*)ws; xbar.x = 0; xbar.st = XST;
    if (lo == 0 && hi == NPHASE) xbar = xcd_barrier_post((unsigned*)ws, XST);
#ifdef DBG_STOP
    if (lo == 100) { dbg_dump(C, out, (const bf16*)(ws + DBG_X), DBG_Y ? (const bf16*)(ws + DBG_Y) : (const bf16*)nullptr); return; }
#endif
#define IN(k) (lo <= (k) && (k) < hi)
#define SEAM(k) do { if (IN(k) && IN((k) + 1)) { if ((k) == 0) cg::this_grid().sync(); else xcd_barrier(xbar); } } while (0)
#define GEMM_CALL(EPI, SCH, g, S, E) pg8::gemm_phase<EPI, SCH, true, true>(C.lds, g, S, E)
    const size_t T1K = (size_t)256 * 1024 * 2;

    if (IN(0)) {
        transpose_mat<1>(C, w_in, 1024, 5632, 512, 512, WQK, nullptr, 0.125f);
        transpose_mat<1>(C, w_in, 1024, 5632, 1024, 512, WQK + (size_t)512 * 1024);
        transpose_mat<0>(C, w_in, 1024, 5632, 0, 512, WFV);
        transpose_mat<0>(C, w_in, 1024, 5632, 1536, 1024, WFV + (size_t)512 * 1024);
        transpose_mat<0>(C, w_in, 1024, 5632, 2560, 1024, WGRET);
        transpose_mat<0>(C, w_in, 1024, 5632, 3584, 1024, WGA, nullptr, -1.4426950408889634f);
        transpose_mat<0>(C, w_in, 1024, 5632, 4608, 1024, WGB, nullptr, -1.4426950408889634f);
        transpose_mat<0>(C, w_ret, 1024, 1024, 0, 1024, WRET);
        transpose_mat<0>(C, w_out, 1024, 1024, 0, 1024, WOUT);
        transpose_mat<2>(C, w_up, 1024, 5632, 0, 5632, WUP, norm2_g);
        transpose_mat<0>(C, w_down, 2816, 1024, 0, 1024, WDOWN);
        fold_w4(C, w_four, W4);
        gen_tab(C, TAB, decay_logit, LG);
        for (int m = C.gw; m < NTOK; m += 2 * C.NGW) { const int m2 = (m + C.NGW < NTOK) ? m + C.NGW : m;
            rms_row2_to_bf16(C.lane, (m < NTOK_P ? x_p + (size_t)m * D : x_s + (size_t)(m - NTOK_P) * D), (m2 < NTOK_P ? x_p + (size_t)m2 * D : x_s + (size_t)(m2 - NTOK_P) * D), norm1_g, XN + (size_t)m * D, XN + (size_t)m2 * D); }
        gen_dm(C, DM);
        __syncthreads();
    }
    SEAM(0);
    if (IN(1)) {
        { pg8::Gemm g{1024, 1024, 1024}; SchedG S; S.so.init(NTOK / 256, 4, G, bx); S.A = (const char*)XN; S.B = (const char*)WQK; S.tsa = T1K; S.tsb = T1K; S.pm_off = 0;
          pg8::EpiRotary E{QK, TAB}; GEMM_CALL(pg8::EpiRotary, SchedG, g, S, E); }
        { pg8::Gemm g{1024, 1024, 1024}; SchedG S; S.so.init(6, NTOK / 256, G, bx); S.A = (const char*)WFV; S.B = (const char*)XN; S.tsa = T1K; S.tsb = T1K; S.pm_off = 0;
          pg8::EpiStoreFV E{FV, FV + (size_t)512 * NTOK}; GEMM_CALL(pg8::EpiStoreFV, SchedG, g, S, E); }
    }
    SEAM(1);
    if (IN(2)) { fold_ft(C, FV); r1_phase(C, QK, VT, LS, LG); }
    SEAM(2);
    if (IN(3)) {
        if (bx < G / 2) { Ctx C2 = C; C2.gtid = bx * 512 + C.tid; C2.NT = (G / 2) * 512; r2_phase(C2, LS, LG); }
#ifndef DBG_NO_DFT
        { pg8::Gemm g{8192, NTOK, SP / 2}; SchedDFT S; S.so.init(2 * 8, 4 * 2, G, (bx + G / 2) % G); S.DM = (const char*)DM; S.FT = (const char*)FV; S.ntile = 8; S.S = SP; S.tok0 = 0; S.lda_b = (size_t)8192 * 2;
          pg8::EpiDFT E{AB, FV, 1.41421356237f}; GEMM_CALL(pg8::EpiDFT, SchedDFT, g, S, E); }
        { pg8::Gemm g{4096, NTOK, SS / 2}; SchedDFT S; S.so.init(2 * 16, 8 * 2, G, bx); S.DM = (const char*)DM; S.FT = (const char*)FV; S.ntile = 16; S.S = SS; S.tok0 = NTOK_P; S.lda_b = (size_t)4096 * 2;
          pg8::EpiDFT E{AB, FV, 1.0f}; GEMM_CALL(pg8::EpiDFT, SchedDFT, g, S, E); }
#endif
        dft_nyquist(C, FV, AB);
    }
    SEAM(3);
    if (IN(4)) { r3_phase(C, QK, VT, LS, OB, LG); }
    SEAM(4);
    if (IN(5)) { pg8::Gemm g{1024, 1024, 1024}; SchedG S; S.so.init(NTOK / 256, 4, G, bx); S.A = (const char*)XN; S.B = (const char*)WGRET; S.tsa = T1K; S.tsb = T1K; S.pm_off = 0;
        pg8::EpiGateSilu E{OB}; GEMM_CALL(pg8::EpiGateSilu, SchedG, g, S, E); }
    SEAM(5);
    if (IN(6)) { pg8::Gemm g{1024, 1024, 1024}; SchedChain S; S.so.init(NTOK / 256, 4, G, bx); S.AB = (const char*)AB; S.ws = (const char*)ws;
        bf16* scr = (bf16*)(ws + WS_SCR) + (size_t)bx * (2 * 65536);
        pg8::EpiChain E{scr, scr + 65536, BA}; GEMM_CALL(pg8::EpiChain, SchedChain, g, S, E); }
    SEAM(6);
    PG8_LAS float* xlds = (PG8_LAS float*)(C.lds + 131072);
    if (IN(7)) {
        { pg8::Gemm g{1024, 1024, 1024}; SchedG S; S.so.init(NTOK_P / 256, 4, G, bx); S.A = (const char*)BA; S.B = (const char*)WOUT; S.tsa = T1K; S.tsb = T1K; S.pm_off = 0;
          pg8::EpiResBf<false> E{x_p, XN, PS1, 0, xlds}; GEMM_CALL(pg8::EpiResBf<false>, SchedG, g, S, E); }
        { pg8::Gemm g{1024, 1024, 1024}; SchedG S; S.so.init(NTOK_S / 256, 4, G, bx); S.A = (const char*)(BA + (size_t)NTOK_P * 1024); S.B = (const char*)WOUT; S.tsa = T1K; S.tsb = T1K; S.pm_off = 0;
          pg8::EpiResBf<false> E{x_s, XN, PS1, NTOK_P, xlds}; GEMM_CALL(pg8::EpiResBf<false>, SchedG, g, S, E); }
    }
    SEAM(7);
    const size_t TDN = (size_t)256 * FF * 2;
    if (IN(8)) { pg8::Gemm g{1024, 1024, 1024}; SchedUp S; S.so.init(323, 22, G, bx); S.XN2 = (const char*)XN; S.W = (const char*)WUP;
        pg8::EpiConvGLU E{ACT, conv_w, conv_b, PS1, xlds}; GEMM_CALL(pg8::EpiConvGLU, SchedUp, g, S, E); }
    SEAM(8);
    if (IN(9)) { pg8::Gemm g{FF, FF, FF}; SchedG S; S.so.init(NTOK / 256, 4, G, bx); S.A = (const char*)ACT; S.B = (const char*)WDOWN; S.tsa = TDN; S.tsb = TDN; S.pm_off = 0;
        pg8::EpiResBf<true> E{XN, X2B, PS2, 0, xlds}; GEMM_CALL(pg8::EpiResBf<true>, SchedG, g, S, E); }
    SEAM(9);
    if (IN(10)) { final_rows(C, X2B, PS2, final_g, out); }
#undef IN
#undef SEAM
}

extern "C" void kernel_launch(void* const* d_in, const int* in_sizes, int n_in, void* d_out, int out_size, void* d_ws, size_t ws_size, hipStream_t stream) {
    static int grid = 0;
    if (grid == 0) {
        if (n_in != 14 || out_size != NTOK * D || ws_size < WS_END) { fprintf(stderr, "kernel_launch: unexpected shapes (n_in %d out %d ws %zu)\n", n_in, out_size, ws_size); grid = -1; return; }
        int dev = 0, cus = 0, per_cu = 0;
        if (hipGetDevice(&dev) != hipSuccess || hipDeviceGetAttribute(&cus, hipDeviceAttributeMultiprocessorCount, dev) != hipSuccess) { grid = -1; return; }
        if (hipFuncSetAttribute((const void*)fwd_kernel, hipFuncAttributeMaxDynamicSharedMemorySize, LDS_BYTES) != hipSuccess) { fprintf(stderr, "kernel_launch: hipFuncSetAttribute failed\n"); grid = -1; return; }
        if (hipOccupancyMaxActiveBlocksPerMultiprocessor(&per_cu, (const void*)fwd_kernel, 512, LDS_BYTES) != hipSuccess || per_cu < 1) { fprintf(stderr, "kernel_launch: occupancy query says %d\n", per_cu); per_cu = 1; }
        (void)hipGetLastError();
        grid = cus * per_cu;
    }
    if (grid < 0) return;
    Args a{};
    for (int i = 0; i < 14; ++i) a.in[i] = (const float*)d_in[i];
    a.out = (float*)d_out; a.ws = (unsigned char*)d_ws;
#if MK_N_LAUNCHES == 1
    a.ph_lo = 0; a.ph_hi = NPHASE;
    if (hipMemsetAsync(d_ws, 0, 16384, stream) != hipSuccess) { fprintf(stderr, "kernel_launch: memset of the barrier words failed\n"); return; }
    void* kargs[] = {&a};
    hipError_t e = hipLaunchCooperativeKernel((const void*)fwd_kernel, dim3(grid), dim3(512), kargs, LDS_BYTES, stream);
    if (e != hipSuccess) fprintf(stderr, "cooperative launch failed: %s (grid %d)\n", hipGetErrorString(e), grid);
#else
#ifdef DBG_STOP
    for (int p = 0; p <= DBG_STOP; ++p) { a.ph_lo = p; a.ph_hi = p + 1; hipLaunchKernelGGL(fwd_kernel, dim3(grid), dim3(512), LDS_BYTES, stream, a); }
    if (DBG_X) { a.ph_lo = 100; a.ph_hi = 101; hipLaunchKernelGGL(fwd_kernel, dim3(grid), dim3(512), LDS_BYTES, stream, a); }
#else
    for (int p = 0; p < NPHASE; ++p) { a.ph_lo = p; a.ph_hi = p + 1; hipLaunchKernelGGL(fwd_kernel, dim3(grid), dim3(512), LDS_BYTES, stream, a); }
#endif
#endif
}
```

```cpp
#include <hip/hip_runtime.h>
#include <hip/hip_cooperative_groups.h>
#include <cstdio>
#include <cstdint>
#include <cmath>
namespace cg = cooperative_groups;

#ifndef MK_N_LAUNCHES
#define MK_N_LAUNCHES 1
#endif

namespace pg8 {
#define PG8_LAS __attribute__((address_space(3)))
typedef unsigned short bf16_t;
typedef short bf16x8 __attribute__((ext_vector_type(8)));
typedef float f32x4 __attribute__((ext_vector_type(4)));
typedef unsigned u32x4 __attribute__((ext_vector_type(4)));
typedef unsigned u32x2 __attribute__((ext_vector_type(2)));
constexpr int BM = 256, BK = 64, HALF = 128, HTB = HALF * BK * 2  , STAGE_BYTES = 8 * HTB, NXCD = 8, WGM = 8;

__host__ __device__ __forceinline__ int lds_byte(int r, int c) { const int st = (r >> 4) * 2 + (c >> 5), rr = r & 15, cc = c & 31, ob = rr * 64 + cc * 2; return st * 1024 + (ob ^ (((ob >> 9) & 1) << 5)); }
__host__ __device__ __forceinline__ void stage_rc(int b, int& R, int& C) { const int st = b / 1024, sb = b % 1024, swz = sb ^ (((sb >> 9) & 1) << 5); R = (st >> 1) * 16 + swz / 64; C = (st & 1) * 32 + (swz % 64) / 2; }
__host__ __device__ __forceinline__ int perm32(int rho) { const int n = rho >> 4, i = rho & 15; return 8 * (i >> 2) + 4 * n + (i & 3); }

struct Unit { int pm, pn; const char* pa; const char* pb; int r0, c0, aux, S; };
struct Gemm { int lda, ldb, K; };

struct StaticOrder {
    int nM, nN, nwg, G, c;
    __host__ __device__ void init(int nM_, int nN_, int G_, int c_) { nM = nM_; nN = nN_; nwg = nM * nN; G = G_; c = c_; }
    __host__ __device__ bool next(int i, Unit& u) const {
        const long L = (long)i * G + c; if (L >= nwg) return false;
        int wgid = (int)L; { const int q = nwg / NXCD, r = nwg % NXCD, xcd = wgid % NXCD, off = wgid / NXCD; wgid = (xcd < r ? xcd * (q + 1) : r * (q + 1) + (xcd - r) * q) + off; }
        const int nig = WGM * nN, gid = wgid / nig, fm = gid * WGM, gsz = (nM - fm) < WGM ? (nM - fm) : WGM;
        u.pm = fm + ((wgid % nig) % gsz); u.pn = (wgid % nig) / gsz; return true;
    }
};

typedef float f32x2_ __attribute__((ext_vector_type(2)));
typedef __bf16 bf16x2_ __attribute__((ext_vector_type(2)));
__device__ __forceinline__ unsigned cvt_pk_bf16(float lo, float hi) { const f32x2_ v = {lo, hi}; const bf16x2_ b = __builtin_convertvector(v, bf16x2_); return __builtin_bit_cast(unsigned, b); }
__device__ __forceinline__ float bflo(unsigned w) { return __uint_as_float(w << 16); }
__device__ __forceinline__ float bfhi(unsigned w) { return __uint_as_float(w & 0xffff0000u); }
__device__ __forceinline__ float sigmoidf_(float x) { return __builtin_amdgcn_rcpf(1.0f + __builtin_amdgcn_exp2f(-1.4426950408889634f * x)); }

#define EPI_LOOP_AM _Pragma("unroll") for (int ai = 0; ai < 2; ++ai) _Pragma("unroll") for (int m = 0; m < 4; ++m)
typedef f32x4 AccT[2][2][4][2];

struct EpiStore {
    static constexpr bool PERM = true, AFTER_DRAIN = false;
    bf16_t* O; int ldc;
    __device__ __forceinline__ void operator()(AccT& acc, const Unit& u, int wr, int wc, int fr, int fq) const {
        const int row0 = u.pm * BM + wr * 64 + fr, col0 = u.pn * BM + wc * 32 + 8 * fq;
        EPI_LOOP_AM { bf16_t* rowp = O + (size_t)(row0 + ai * HALF + m * 16) * ldc + col0;
#pragma unroll
            for (int bj = 0; bj < 2; ++bj) { const f32x4 v0 = acc[ai][bj][m][0], v1 = acc[ai][bj][m][1];
                u32x4 w; w.x = cvt_pk_bf16(v0[0], v0[1]); w.y = cvt_pk_bf16(v0[2], v0[3]); w.z = cvt_pk_bf16(v1[0], v1[1]); w.w = cvt_pk_bf16(v1[2], v1[3]);
                *(u32x4*)(rowp + bj * HALF) = w; } }
    }
};

struct EpiStoreFV {
    static constexpr bool PERM = true, AFTER_DRAIN = false;
    bf16_t* FT; bf16_t* VTt;
    __device__ __forceinline__ void operator()(AccT& acc, const Unit& u, int wr, int wc, int fr, int fq) const {
        const int row0 = u.pm * BM + wr * 64 + fr, col0 = u.pn * BM + wc * 32 + 8 * fq;
        bf16_t* base; size_t s_m, s_ai, s_bj;
        if (u.pm < 2) { base = FT + (size_t)row0 * 81920 + col0; s_m = (size_t)16 * 81920; s_ai = (size_t)128 * 81920; s_bj = 128; }
        else { const int r = row0 - 512; base = VTt + ((size_t)((col0 >> 7) * 8 + (r >> 7)) * 128 + (r & 127)) * 128 + (col0 & 127); s_m = 16 * 128; s_ai = (size_t)128 * 128; s_bj = (size_t)8 * 128 * 128; }
        EPI_LOOP_AM { bf16_t* rowp = base + ai * s_ai + m * s_m;
#pragma unroll
            for (int bj = 0; bj < 2; ++bj) { const f32x4 v0 = acc[ai][bj][m][0], v1 = acc[ai][bj][m][1];
                u32x4 w; w.x = cvt_pk_bf16(v0[0], v0[1]); w.y = cvt_pk_bf16(v0[2], v0[3]); w.z = cvt_pk_bf16(v1[0], v1[1]); w.w = cvt_pk_bf16(v1[2], v1[3]);
                *(u32x4*)(rowp + bj * s_bj) = w; } }
    }
};

struct EpiDFT {
    static constexpr bool PERM = true, AFTER_DRAIN = false;
    bf16_t* AB; const bf16_t* FT; float scale;
    __device__ __forceinline__ void operator()(AccT& acc, const Unit& u, int wr, int wc, int fr, int fq) const {
        const int n0 = u.pm * BM + wr * 64 + fr, col0 = u.c0 + wc * 32 + 8 * fq; const bool sinp = u.aux != 0;
        float fn[2][8];
#pragma unroll
        for (int bj = 0; bj < 2; ++bj)
#pragma unroll
            for (int k = 0; k < 8; ++k) fn[bj][k] = sinp ? 0.f : bflo((unsigned)FT[(size_t)((col0 & 511) + bj * HALF + k) * 81920 + u.r0 + (u.S >> 1)]) * (1.0f / 1024.0f);
        EPI_LOOP_AM { const int n = n0 + ai * HALF + m * 16; const float sg = (n & 1) ? -1.f : 1.f;
            const float s1 = sinp ? -sg * scale : scale, s2 = sinp ? -s1 : s1, sn = sg * scale;
            bf16_t* p1 = AB + (size_t)(u.r0 + n) * 1024 + col0; bf16_t* p2 = AB + (size_t)(u.r0 + u.S - n) * 1024 + col0;
#pragma unroll
            for (int bj = 0; bj < 2; ++bj) { const f32x4 v0 = acc[ai][bj][m][0], v1 = acc[ai][bj][m][1];
                float r[8] = {v0[0], v0[1], v0[2], v0[3], v1[0], v1[1], v1[2], v1[3]};
#pragma unroll
                for (int k = 0; k < 8; ++k) r[k] = r[k] * s1 + sn * fn[bj][k];
                u32x4 w; w.x = cvt_pk_bf16(r[0], r[1]); w.y = cvt_pk_bf16(r[2], r[3]); w.z = cvt_pk_bf16(r[4], r[5]); w.w = cvt_pk_bf16(r[6], r[7]);
                *(u32x4*)(p1 + bj * HALF) = w;
                if (n > 0) { const float t = sinp ? -1.f : 1.f; u32x4 x; x.x = cvt_pk_bf16(r[0] * t, r[1] * t); x.y = cvt_pk_bf16(r[2] * t, r[3] * t); x.z = cvt_pk_bf16(r[4] * t, r[5] * t); x.w = cvt_pk_bf16(r[6] * t, r[7] * t);
                    *(u32x4*)(p2 + bj * HALF) = x; } } }
    }
};

typedef float f32x2v __attribute__((ext_vector_type(2)));
struct EpiGateSilu {
    static constexpr bool PERM = true, AFTER_DRAIN = false;
    bf16_t* O;
    __device__ __forceinline__ void operator()(AccT& acc, const Unit& u, int wr, int wc, int fr, int fq) const {
        const int row0 = u.pm * BM + wr * 64 + fr, col0 = u.pn * BM + wc * 32 + 8 * fq;
        bf16_t* base = O + (size_t)row0 * 1024 + col0;
        u32x4 ov[2][4][2];
        EPI_LOOP_AM {
#pragma unroll
            for (int bj = 0; bj < 2; ++bj) ov[ai][m][bj] = *(const u32x4*)(base + (ai * HALF + m * 16) * 1024 + bj * HALF); }
        EPI_LOOP_AM {
#pragma unroll
            for (int bj = 0; bj < 2; ++bj) { const u32x4 o = ov[ai][m][bj]; const unsigned owd[4] = {o.x, o.y, o.z, o.w}; unsigned rw[4];
#pragma unroll
                for (int k = 0; k < 4; ++k) { const f32x4 gq = acc[ai][bj][m][k >> 1]; const f32x2v g = (k & 1) ? (f32x2v){gq[2], gq[3]} : (f32x2v){gq[0], gq[1]};
                    const f32x2v t = g * (-1.4426950408889634f); f32x2v e; e.x = __builtin_amdgcn_exp2f(t.x); e.y = __builtin_amdgcn_exp2f(t.y); const f32x2v d = e + 1.0f;
                    f32x2v s; s.x = __builtin_amdgcn_rcpf(d.x); s.y = __builtin_amdgcn_rcpf(d.y);
                    const f32x2v ovv = {bflo(owd[k]), bfhi(owd[k])}; const f32x2v r = (ovv * g) * s; rw[k] = cvt_pk_bf16(r.x, r.y); }
                u32x4 w; w.x = rw[0]; w.y = rw[1]; w.z = rw[2]; w.w = rw[3];
                *(u32x4*)(base + (ai * HALF + m * 16) * 1024 + bj * HALF) = w; } }
    }
};

template <int MODE> struct EpiGateSig {
    static constexpr bool PERM = true, AFTER_DRAIN = false;
    bf16_t* BA; const bf16_t* BB;
    __device__ __forceinline__ void operator()(AccT& acc, const Unit& u, int wr, int wc, int fr, int fq) const {
        const int row0 = u.pm * BM + wr * 64 + fr, col0 = u.pn * BM + wc * 32 + 8 * fq;
        const size_t off0 = (size_t)row0 * 1024 + col0;
#pragma unroll
        for (int ai = 0; ai < 2; ++ai) {
            u32x4 av[4][2], bv[4][2];
#pragma unroll
            for (int m = 0; m < 4; ++m)
#pragma unroll
                for (int bj = 0; bj < 2; ++bj) { av[m][bj] = *(const u32x4*)(BA + off0 + (ai * HALF + m * 16) * 1024 + bj * HALF); if (MODE == 1) bv[m][bj] = *(const u32x4*)(BB + off0 + (ai * HALF + m * 16) * 1024 + bj * HALF); }
#pragma unroll
            for (int m = 0; m < 4; ++m)
#pragma unroll
                for (int bj = 0; bj < 2; ++bj) { const f32x4 g0 = acc[ai][bj][m][0], g1 = acc[ai][bj][m][1]; const u32x4 a = av[m][bj];
                    float r[8]; const float gg[8] = {g0[0], g0[1], g0[2], g0[3], g1[0], g1[1], g1[2], g1[3]}; const float aa[8] = {bflo(a.x), bfhi(a.x), bflo(a.y), bfhi(a.y), bflo(a.z), bfhi(a.z), bflo(a.w), bfhi(a.w)};
                    if (MODE == 0) {
#pragma unroll
                        for (int k = 0; k < 8; ++k) r[k] = aa[k] * sigmoidf_(gg[k]);
                    } else { const u32x4 b = bv[m][bj]; const float bb[8] = {bflo(b.x), bfhi(b.x), bflo(b.y), bfhi(b.y), bflo(b.z), bfhi(b.z), bflo(b.w), bfhi(b.w)};
#pragma unroll
                        for (int k = 0; k < 8; ++k) r[k] = aa[k] + bb[k] * sigmoidf_(gg[k]);
                    }
                    u32x4 w; w.x = cvt_pk_bf16(r[0], r[1]); w.y = cvt_pk_bf16(r[2], r[3]); w.z = cvt_pk_bf16(r[4], r[5]); w.w = cvt_pk_bf16(r[6], r[7]);
                    *(u32x4*)(BA + off0 + (ai * HALF + m * 16) * 1024 + bj * HALF) = w; }
        }
    }
};

typedef float f32x2 __attribute__((ext_vector_type(2)));
struct EpiChain {
    static constexpr bool PERM = true, AFTER_DRAIN = false;
    bf16_t* SA; bf16_t* SB; bf16_t* BA;
    __device__ __forceinline__ void operator()(AccT& acc, const Unit& u, int wr, int wc, int fr, int fq) const {
        int frr = fr, fqq = fq; asm volatile("" : "+v"(frr), "+v"(fqq));
        const int st = u.aux; const int loff = (wr * 64 + frr) * 256 + wc * 32 + 8 * fqq;
        if (st == 0 || st == 2) { bf16_t* T = (st == 0) ? SA : SB;
            EPI_LOOP_AM {
#pragma unroll
                for (int bj = 0; bj < 2; ++bj) { const f32x4 v0 = acc[ai][bj][m][0], v1 = acc[ai][bj][m][1];
                    u32x4 w; w.x = cvt_pk_bf16(v0[0], v0[1]); w.y = cvt_pk_bf16(v0[2], v0[3]); w.z = cvt_pk_bf16(v1[0], v1[1]); w.w = cvt_pk_bf16(v1[2], v1[3]);
                    *(u32x4*)(T + loff + (ai * HALF + m * 16) * 256 + bj * HALF) = w; } }
        } else if (st == 1) {
            EPI_LOOP_AM {
#pragma unroll
                for (int bj = 0; bj < 2; ++bj) { const int lo = loff + (ai * HALF + m * 16) * 256 + bj * HALF; const u32x4 a = *(const u32x4*)(SA + lo);
                    const unsigned aw[4] = {a.x, a.y, a.z, a.w}; unsigned ow[4];
#pragma unroll
                    for (int k = 0; k < 4; ++k) { const f32x4 gq = acc[ai][bj][m][k >> 1]; const f32x2 g = (k & 1) ? (f32x2){gq[2], gq[3]} : (f32x2){gq[0], gq[1]};
                        f32x2 e; e.x = __builtin_amdgcn_exp2f(g.x); e.y = __builtin_amdgcn_exp2f(g.y);     const f32x2 d = e + 1.0f;
                        f32x2 s; s.x = __builtin_amdgcn_rcpf(d.x); s.y = __builtin_amdgcn_rcpf(d.y);
                        const f32x2 av = {bflo(aw[k]), bfhi(aw[k])}; const f32x2 r = av * s; ow[k] = cvt_pk_bf16(r.x, r.y); }
                    u32x4 w; w.x = ow[0]; w.y = ow[1]; w.z = ow[2]; w.w = ow[3]; *(u32x4*)(SA + lo) = w; } }
        } else {
            bf16_t* gout = BA + (size_t)(u.pm * BM + wr * 64 + frr) * 1024 + u.pn * BM + wc * 32 + 8 * fqq;
            EPI_LOOP_AM {
#pragma unroll
                for (int bj = 0; bj < 2; ++bj) { const int lo = loff + (ai * HALF + m * 16) * 256 + bj * HALF; const u32x4 a = *(const u32x4*)(SA + lo), b = *(const u32x4*)(SB + lo);
                    const unsigned aw[4] = {a.x, a.y, a.z, a.w}, bw[4] = {b.x, b.y, b.z, b.w}; unsigned ow[4];
#pragma unroll
                    for (int k = 0; k < 4; ++k) { const f32x4 gq = acc[ai][bj][m][k >> 1]; const f32x2 g = (k & 1) ? (f32x2){gq[2], gq[3]} : (f32x2){gq[0], gq[1]};
                        f32x2 e; e.x = __builtin_amdgcn_exp2f(g.x); e.y = __builtin_amdgcn_exp2f(g.y);     const f32x2 d = e + 1.0f;
                        f32x2 s; s.x = __builtin_amdgcn_rcpf(d.x); s.y = __builtin_amdgcn_rcpf(d.y);
                        const f32x2 av = {bflo(aw[k]), bfhi(aw[k])}, bv = {bflo(bw[k]), bfhi(bw[k])}; const f32x2 r = bv * s + av; ow[k] = cvt_pk_bf16(r.x, r.y); }
                    u32x4 w; w.x = ow[0]; w.y = ow[1]; w.z = ow[2]; w.w = ow[3]; *(u32x4*)(gout + (size_t)(ai * HALF + m * 16) * 1024 + bj * HALF) = w; } }
        }
    }
};


__device__ __forceinline__ f32x2 gelu_pk(f32x2 v) {
    const f32x2 av = __builtin_elementwise_abs(v), d = av * 0.2316418882f + 1.0f;
    f32x2 t; t.x = __builtin_amdgcn_rcpf(d.x); t.y = __builtin_amdgcn_rcpf(d.y);
    f32x2 q = t * 0.5307027145f + (-0.7265760135f); q = q * t + 0.7107068705f; q = q * t + (-0.142248368f); q = q * t + 0.127414796f; q = q * t;
    const f32x2 s = (v * v) * (-0.72134752044f);
    f32x2 e; e.x = __builtin_amdgcn_exp2f(s.x); e.y = __builtin_amdgcn_exp2f(s.y);
    const f32x2 m = v * (q * e), r = v - m;
    f32x2 o; o.x = v.x < 0.f ? m.x : r.x; o.y = v.y < 0.f ? m.y : r.y; return o;
}
__device__ __forceinline__ float dpp_ror1(float v)  { return __builtin_bit_cast(float, __builtin_amdgcn_update_dpp(0, __builtin_bit_cast(int, v), 0x121, 0xF, 0xF, false)); }
__device__ __forceinline__ float dpp_shr1_old(float old, float v) { return __builtin_bit_cast(float, __builtin_amdgcn_update_dpp(__builtin_bit_cast(int, old), __builtin_bit_cast(int, v), 0x111, 0xF, 0xF, false)); }
__device__ __forceinline__ float dpp_shl1_old(float old, float v) { return __builtin_bit_cast(float, __builtin_amdgcn_update_dpp(__builtin_bit_cast(int, old), __builtin_bit_cast(int, v), 0x101, 0xF, 0xF, false)); }
__device__ __forceinline__ float dpp_ror15(float v) { return __builtin_bit_cast(float, __builtin_amdgcn_update_dpp(0, __builtin_bit_cast(int, v), 0x12F, 0xF, 0xF, false)); }

struct EpiConvGLU {
    static constexpr bool PERM = true, AFTER_DRAIN = false;
    bf16_t* ACT; const float* cw; const float* cb; const float* PS; PG8_LAS float* xch;
    __device__ __forceinline__ void operator()(AccT& acc, const Unit& u, int wr, int wc, int fr, int fq) const {
        const int wid = wr * 4 + wc; PG8_LAS float* my = xch + wid * 128;
        EPI_LOOP_AM { const int gr = u.c0 + ai * HALF + wr * 64 + 4 * fr + m; const int grow = gr < 0 ? 0 : (gr >= 81920 ? 81919 : gr);
            const f32x4 p = *(const f32x4*)(PS + (size_t)grow * 4); const float rr = __builtin_amdgcn_rsqf(((p[0] + p[1]) + (p[2] + p[3])) * (1.0f / 1024.0f) + 1e-6f);
#pragma unroll
            for (int bj = 0; bj < 2; ++bj)
#pragma unroll
                for (int n = 0; n < 2; ++n) acc[ai][bj][m][n] = acc[ai][bj][m][n] * rr; }
        if (fr == 0) {
#pragma unroll
            for (int ai = 0; ai < 2; ++ai) { *(PG8_LAS f32x4*)(my + (ai * 2 + 0) * 32 + fq * 8) = acc[ai][0][0][0]; *(PG8_LAS f32x4*)(my + (ai * 2 + 0) * 32 + fq * 8 + 4) = acc[ai][0][0][1]; } }
        if (fr == 15) {
#pragma unroll
            for (int ai = 0; ai < 2; ++ai) { *(PG8_LAS f32x4*)(my + (ai * 2 + 1) * 32 + fq * 8) = acc[ai][0][3][0]; *(PG8_LAS f32x4*)(my + (ai * 2 + 1) * 32 + fq * 8 + 4) = acc[ai][0][3][1]; } }
        asm volatile("s_waitcnt lgkmcnt(0)" ::: "memory"); __builtin_amdgcn_s_barrier(); asm volatile("" ::: "memory");
        const int ch0 = u.pn * 128 + wc * 32 + fq * 8;
        const bool anyb = ((u.c0 + 256) >> 12) != (u.c0 >> 12);
        f32x4 cwv[2][4];
#pragma unroll
        for (int n = 0; n < 2; ++n) { cwv[n][0] = *(const f32x4*)(cw + ch0 + 4 * n); cwv[n][1] = *(const f32x4*)(cw + 2816 + ch0 + 4 * n); cwv[n][2] = *(const f32x4*)(cw + 5632 + ch0 + 4 * n); cwv[n][3] = *(const f32x4*)(cb + ch0 + 4 * n); }
#pragma unroll
        for (int ai = 0; ai < 2; ++ai) {
            const bool hasp = (wr == 1) || (ai == 1), hasn = (wr == 0) || (ai == 0);
            const PG8_LAS float* pp = xch + (wr == 1 ? (wid - 4) * 128 + (ai * 2 + 1) * 32 : (wid + 4) * 128 + (0 * 2 + 1) * 32) + fq * 8;
            const PG8_LAS float* pn_ = xch + (wr == 0 ? (wid + 4) * 128 + (ai * 2 + 0) * 32 : (wid - 4) * 128 + (1 * 2 + 0) * 32) + fq * 8;
            f32x4 upE[2], dnE[2];
#pragma unroll
            for (int n = 0; n < 2; ++n) { f32x4 pv = (f32x4){0.f, 0.f, 0.f, 0.f}, nv = (f32x4){0.f, 0.f, 0.f, 0.f}; if (hasp) pv = *(const PG8_LAS f32x4*)(pp + 4 * n); if (hasn) nv = *(const PG8_LAS f32x4*)(pn_ + 4 * n);
#pragma unroll
                for (int j = 0; j < 4; ++j) { upE[n][j] = dpp_shr1_old(pv[j], acc[ai][0][3][n][j]); dnE[n][j] = dpp_shl1_old(nv[j], acc[ai][0][0][n][j]); } }
#pragma unroll
            for (int m = 0; m < 4; ++m) {
                const int r = ai * HALF + wr * 64 + 4 * fr + m, gr = u.c0 + r; const int S = gr < 16384 ? 4096 : 8192, pos = gr & (S - 1);
                u32x4 w4;
#pragma unroll
                for (int n = 0; n < 2; ++n) {
                    f32x4 up = (m == 0) ? upE[n] : acc[ai][0][m > 0 ? m - 1 : 0][n], dn = (m == 3) ? dnE[n] : acc[ai][0][m < 3 ? m + 1 : 3][n];
                    if (anyb) { if (pos == 0) up = (f32x4){0.f, 0.f, 0.f, 0.f}; if (pos == S - 1) dn = (f32x4){0.f, 0.f, 0.f, 0.f}; }
                    const f32x4 x = cwv[n][0] * up + cwv[n][1] * acc[ai][0][m][n] + cwv[n][2] * dn + cwv[n][3], vv = acc[ai][1][m][n];
                    const f32x2 ga = gelu_pk((f32x2){x[0], x[1]}), gb = gelu_pk((f32x2){x[2], x[3]});
                    const unsigned lo = cvt_pk_bf16(ga.x * vv[0], ga.y * vv[1]), hi = cvt_pk_bf16(gb.x * vv[2], gb.y * vv[3]);
                    if (n == 0) { w4.x = lo; w4.y = hi; } else { w4.z = lo; w4.w = hi; }
                }
                if (r >= 1 && r <= 254 && gr < 81920) __builtin_nontemporal_store(w4, (u32x4*)(ACT + (size_t)gr * 2816 + ch0));
            }
        }
    }
};

template <bool BASE_BF16> struct EpiResBf {
    static constexpr bool PERM = true, AFTER_DRAIN = false;
    const void* base; bf16_t* Y; float* PS; int grow0; PG8_LAS float* xs;
    __device__ __forceinline__ void operator()(AccT& acc, const Unit& u, int wr, int wc, int fr, int fq) const {
        const int row0 = u.pm * BM + wr * 64 + fr, col0 = u.pn * BM + wc * 32 + 8 * fq;
        const size_t off0 = (size_t)row0 * 1024 + col0;
#pragma unroll
        for (int ai = 0; ai < 2; ++ai) {
            f32x4 bs[4][2][2];
#pragma unroll
            for (int m = 0; m < 4; ++m)
#pragma unroll
                for (int bj = 0; bj < 2; ++bj) { const size_t off = off0 + (size_t)(ai * HALF + m * 16) * 1024 + bj * HALF;
                    if (BASE_BF16) { const u32x4 w = *(const u32x4*)((const bf16_t*)base + off); bs[m][bj][0] = (f32x4){bflo(w.x), bfhi(w.x), bflo(w.y), bfhi(w.y)}; bs[m][bj][1] = (f32x4){bflo(w.z), bfhi(w.z), bflo(w.w), bfhi(w.w)}; }
                    else { bs[m][bj][0] = *(const f32x4*)((const float*)base + off); bs[m][bj][1] = *(const f32x4*)((const float*)base + off + 4); } }
#pragma unroll
            for (int m = 0; m < 4; ++m) { const size_t offy = off0 + (size_t)(ai * HALF + m * 16) * 1024 + (size_t)grow0 * 1024; f32x4 sv = (f32x4){0.f, 0.f, 0.f, 0.f};
#pragma unroll
                for (int bj = 0; bj < 2; ++bj) { const f32x4 y0 = bs[m][bj][0] + acc[ai][bj][m][0], y1 = bs[m][bj][1] + acc[ai][bj][m][1];
                    sv = sv + y0 * y0; sv = sv + y1 * y1;
                    u32x4 o; o.x = cvt_pk_bf16(y0[0], y0[1]); o.y = cvt_pk_bf16(y0[2], y0[3]); o.z = cvt_pk_bf16(y1[0], y1[1]); o.w = cvt_pk_bf16(y1[2], y1[3]); *(u32x4*)(Y + offy + bj * HALF) = o; }
                float s = (sv[0] + sv[1]) + (sv[2] + sv[3]);
                { const auto r16 = __builtin_amdgcn_permlane16_swap(__float_as_uint(s), __float_as_uint(s), false, false); s = __uint_as_float(r16[0]) + __uint_as_float(r16[1]); }
                { const auto r32 = __builtin_amdgcn_permlane32_swap(__float_as_uint(s), __float_as_uint(s), false, false); s = __uint_as_float(r32[0]) + __uint_as_float(r32[1]); }
                if (fq == 0) xs[(ai * HALF + wr * 64 + m * 16 + fr) * 4 + wc] = s; }
        }
        asm volatile("s_waitcnt lgkmcnt(0)" ::: "memory"); __builtin_amdgcn_s_barrier(); asm volatile("" ::: "memory");
        const int tid = (wr * 4 + wc) * 64 + fq * 16 + fr;
        if (tid < 256) { const f32x4 p = *(const PG8_LAS f32x4*)(xs + tid * 4); PS[(size_t)(grow0 + u.pm * BM + tid) * 4 + u.pn] = (p[0] + p[1]) + (p[2] + p[3]); }
    }
};

struct EpiRotary {
    static constexpr bool PERM = true, AFTER_DRAIN = false;
    bf16_t* QK; const float* tab;
    __device__ __forceinline__ void operator()(AccT& acc, const Unit& u, int wr, int wc, int fr, int fq) const {
        const int row0 = u.pm * BM + wr * 64 + fr; const int S = (u.pm < 64) ? 4096 : 8192; const float sc = (u.pn < 2) ? 0.125f : 1.0f;
        const int part = u.pn >> 1, hb = (u.pn & 1) * 4 + (wc >> 1), d0 = 32 * (wc & 1) + 8 * fq, p0 = 16 * (wc & 1) + 4 * fq;
        bf16_t* qbase = QK + ((((size_t)part * 640 + 2 * u.pm) * 8 + hb) * 128 + wr * 64 + fr) * 64 + d0;
        f32x4 tb[2][4][2];
        EPI_LOOP_AM { const int t = row0 + ai * HALF + m * 16, pos = t & (S - 1); const float* tp = tab + ((size_t)pos * 32 + p0) * 2; tb[ai][m][0] = *(const f32x4*)tp; tb[ai][m][1] = *(const f32x4*)(tp + 4); }
        EPI_LOOP_AM { const f32x4 t0 = tb[ai][m][0], t1 = tb[ai][m][1];
            const f32x4 cs = {t0[0], t0[2], t1[0], t1[2]}, sn = {t0[1], t0[3], t1[1], t1[3]};
#pragma unroll
            for (int bj = 0; bj < 2; ++bj) { const f32x4 x1 = acc[ai][bj][m][0], x2 = acc[ai][bj][m][1];
                const f32x4 y1 = x1 * cs - x2 * sn, y2 = x1 * sn + x2 * cs;
                u32x4 w; w.x = cvt_pk_bf16(y1[0], y1[1]); w.y = cvt_pk_bf16(y1[2], y1[3]); w.z = cvt_pk_bf16(y2[0], y2[1]); w.w = cvt_pk_bf16(y2[2], y2[3]);
                *(u32x4*)(qbase + ai * (8 * 128 * 64) + m * (16 * 64) + bj * (2 * 128 * 64)) = w; } }
    }
};

template <class E> struct ARowPerm { static constexpr bool value = false; };
template <> struct ARowPerm<EpiConvGLU> { static constexpr bool value = true; };
template <class Epi, class Sched, bool ALIGN_EPI = false, bool SP2 = false>
__device__ __forceinline__ void gemm_phase(PG8_LAS unsigned char* lds, const Gemm g, const Sched& S, const Epi& E) {
    const int tid = threadIdx.x, wid = __builtin_amdgcn_readfirstlane(tid >> 6), lane = tid & 63, wr = wid >> 2, wc = wid & 3, fr = lane & 15, fq = lane >> 4;
    const int K = g.K, nt = K / BK;
    unsigned voffA[2], voffB[2];
#pragma unroll
    for (int i = 0; i < 2; ++i) { int R, C; stage_rc(tid * 16 + i * 8192, R, C); const int Rb = Epi::PERM ? ((R & ~31) + perm32(R & 31)) : R;
        const int Ra = ARowPerm<Epi>::value ? ((R & ~63) + 4 * (R & 15) + ((R >> 4) & 3)) : R;
        voffA[i] = (unsigned)(Ra * g.lda + C) * 2u; voffB[i] = (unsigned)(Rb * g.ldb + C) * 2u; }
    const size_t kstep = (size_t)(BK * 2);
    const size_t hsA = (size_t)HALF * g.lda * 2, hsB = (size_t)HALF * g.ldb * 2;
    const unsigned ldsw = (unsigned)wid * 1024u;
    const int aoff = lds_byte(wr * 64 + fr, fq * 8), boff = lds_byte(wc * 32 + fr, fq * 8);
#define PG8_SA(b, h) (((b) * 2 + (h)) * HTB)
#define PG8_SB(b, h) ((4 + (b) * 2 + (h)) * HTB)
#define PG8_STAGE(bufoff, gbase, voff) do { _Pragma("unroll") for (int _i = 0; _i < 2; ++_i) \
        __builtin_amdgcn_global_load_lds((const unsigned*)((const char*)(gbase) + (voff)[_i]), (PG8_LAS unsigned*)(lds + (bufoff) + ldsw + _i * 8192), 16, 0, 0); } while (0)
#define PG8_LDA(dst, b, h) do { _Pragma("unroll") for (int m = 0; m < 4; ++m) _Pragma("unroll") for (int k = 0; k < 2; ++k) dst[m][k] = *(const PG8_LAS bf16x8*)(lds + PG8_SA(b, h) + aoff + m * 2048 + k * 1024); } while (0)
#define PG8_LDB(dst, b, h) do { _Pragma("unroll") for (int n = 0; n < 2; ++n) _Pragma("unroll") for (int k = 0; k < 2; ++k) dst[n][k] = *(const PG8_LAS bf16x8*)(lds + PG8_SB(b, h) + boff + n * 2048 + k * 1024); } while (0)
#define PG8_MMA(ai, bj, At, Bt) do { __builtin_amdgcn_s_setprio(1); _Pragma("unroll") for (int m = 0; m < 4; ++m) _Pragma("unroll") for (int n = 0; n < 2; ++n) _Pragma("unroll") for (int k = 0; k < 2; ++k) \
        acc[ai][bj][m][n] = __builtin_amdgcn_mfma_f32_16x16x32_bf16(Bt[n][k], At[m][k], acc[ai][bj][m][n], 0, 0, 0); __builtin_amdgcn_s_setprio(0); } while (0)
#define PG8_WAIT_V(n) asm volatile("s_waitcnt vmcnt(" #n ")" ::: "memory")
#define PG8_WAIT_L(n) asm volatile("s_waitcnt lgkmcnt(" #n ")" ::: "memory")
#define PG8_BAR __builtin_amdgcn_s_barrier()
#define PG8_SCHED __builtin_amdgcn_sched_barrier(0)
    Unit cur, nxt; int ui = 0;
    if (!S.next(0, cur)) return;
    f32x4 acc[2][2][4][2];
#pragma unroll
    for (int a = 0; a < 2; ++a)
#pragma unroll
        for (int b = 0; b < 2; ++b)
#pragma unroll
            for (int m = 0; m < 4; ++m)
#pragma unroll
                for (int n = 0; n < 2; ++n) acc[a][b][m][n] = (f32x4){0.f, 0.f, 0.f, 0.f};
    bf16x8 At[4][2], B0[2][2], B1[2][2];
    const char* cA = cur.pa; const char* cB = cur.pb;

    if constexpr (SP2) {
        PG8_STAGE(PG8_SB(0, 0), cB, voffB); PG8_STAGE(PG8_SB(0, 1), cB + hsB, voffB); PG8_STAGE(PG8_SA(0, 0), cA, voffA); PG8_STAGE(PG8_SA(0, 1), cA + hsA, voffA);
        if (wr == 1) PG8_BAR;
        PG8_WAIT_V(2); PG8_BAR;
        PG8_STAGE(PG8_SB(1, 0), cB + kstep, voffB); PG8_STAGE(PG8_SA(1, 0), cA + kstep, voffA); PG8_STAGE(PG8_SB(1, 1), cB + hsB + kstep, voffB);
        PG8_WAIT_V(6); PG8_BAR;
    } else {
        PG8_STAGE(PG8_SB(0, 0), cB, voffB); PG8_STAGE(PG8_SA(0, 0), cA, voffA); PG8_STAGE(PG8_SB(0, 1), cB + hsB, voffB); PG8_STAGE(PG8_SA(0, 1), cA + hsA, voffA);
        if (wr == 1) PG8_BAR;
        PG8_WAIT_V(4); PG8_BAR;
        PG8_STAGE(PG8_SB(1, 0), cB + kstep, voffB); PG8_STAGE(PG8_SA(1, 0), cA + kstep, voffA); PG8_STAGE(PG8_SB(1, 1), cB + hsB + kstep, voffB);
        PG8_WAIT_V(6); PG8_BAR;
    }
    for (;;) {
        const bool has_next = S.next(ui + 1, nxt);
        const char* nA = has_next ? nxt.pa : cA; const char* nB = has_next ? nxt.pb : cB;
        for (int t = 0; t < nt; t += 2) {
            const bool last = (t == nt - 2);
            const char* a1 = cA + (size_t)(t + 1) * kstep;
            const char* a2 = last ? nA : cA + (size_t)(t + 2) * kstep; const char* b2 = last ? nB : cB + (size_t)(t + 2) * kstep;
            const char* a3 = a2 + kstep; const char* b3 = b2 + kstep;

            if constexpr (SP2) {
            PG8_LDB(B0, 0, 0); PG8_LDB(B1, 0, 1); PG8_SCHED; PG8_LDA(At, 0, 0); PG8_STAGE(PG8_SA(1, 1), a1 + hsA, voffA);
            PG8_WAIT_V(8); PG8_WAIT_L(0); PG8_BAR; PG8_MMA(0, 0, At, B0); PG8_MMA(0, 1, At, B1); PG8_BAR; PG8_SCHED;
            PG8_LDA(At, 0, 1); PG8_STAGE(PG8_SB(0, 0), b2, voffB); PG8_STAGE(PG8_SB(0, 1), b2 + hsB, voffB); PG8_STAGE(PG8_SA(0, 0), a2, voffA);
            PG8_WAIT_V(8); PG8_WAIT_L(0); PG8_BAR; PG8_MMA(1, 0, At, B0); PG8_MMA(1, 1, At, B1); PG8_BAR; PG8_SCHED;
            PG8_LDB(B0, 1, 0); PG8_LDB(B1, 1, 1); PG8_SCHED; PG8_LDA(At, 1, 0); PG8_STAGE(PG8_SA(0, 1), a2 + hsA, voffA);
            PG8_WAIT_V(8); PG8_WAIT_L(0); PG8_BAR; PG8_MMA(0, 0, At, B0); PG8_MMA(0, 1, At, B1); PG8_BAR; PG8_SCHED;
            PG8_LDA(At, 1, 1); PG8_STAGE(PG8_SB(1, 0), b3, voffB); PG8_STAGE(PG8_SB(1, 1), b3 + hsB, voffB); PG8_STAGE(PG8_SA(1, 0), a3, voffA);
            PG8_WAIT_V(8); PG8_WAIT_L(0); PG8_BAR; PG8_MMA(1, 0, At, B0); PG8_MMA(1, 1, At, B1); PG8_BAR; PG8_SCHED;
            } else {
            PG8_LDB(B0, 0, 0); PG8_SCHED; PG8_LDA(At, 0, 0); PG8_STAGE(PG8_SA(1, 1), a1 + hsA, voffA);
            PG8_WAIT_L(8); PG8_BAR; PG8_WAIT_L(0); PG8_MMA(0, 0, At, B0); PG8_BAR; PG8_SCHED;
            PG8_LDB(B1, 0, 1); PG8_STAGE(PG8_SB(0, 0), b2, voffB);
            PG8_BAR; PG8_WAIT_L(0); PG8_MMA(0, 1, At, B1); PG8_BAR;
            PG8_LDA(At, 0, 1); PG8_STAGE(PG8_SA(0, 0), a2, voffA);
            PG8_BAR; PG8_WAIT_L(0); PG8_MMA(1, 0, At, B0); PG8_BAR; PG8_SCHED;
            PG8_STAGE(PG8_SB(0, 1), b2 + hsB, voffB);
            PG8_WAIT_V(6); PG8_BAR; PG8_MMA(1, 1, At, B1); PG8_BAR;
            PG8_LDB(B0, 1, 0); PG8_SCHED; PG8_LDA(At, 1, 0); PG8_STAGE(PG8_SA(0, 1), a2 + hsA, voffA);
            PG8_WAIT_L(8); PG8_BAR; PG8_WAIT_L(0); PG8_MMA(0, 0, At, B0); PG8_BAR; PG8_SCHED;
            PG8_LDB(B1, 1, 1); PG8_STAGE(PG8_SB(1, 0), b3, voffB);
            PG8_BAR; PG8_WAIT_L(0); PG8_MMA(0, 1, At, B1); PG8_BAR;
            PG8_LDA(At, 1, 1); PG8_STAGE(PG8_SA(1, 0), a3, voffA);
            PG8_BAR; PG8_WAIT_L(0); PG8_MMA(1, 0, At, B0); PG8_BAR; PG8_SCHED;
            PG8_STAGE(PG8_SB(1, 1), b3 + hsB, voffB);
            PG8_WAIT_V(6); PG8_BAR; PG8_MMA(1, 1, At, B1); PG8_BAR;
            }
        }
        if constexpr (ALIGN_EPI) { if (wr == 0) PG8_BAR; }
        if constexpr (!Epi::AFTER_DRAIN) { E(acc, cur, wr, wc, fr, fq); }
        if (!has_next) break;
#pragma unroll
        for (int a = 0; a < 2; ++a)
#pragma unroll
            for (int b = 0; b < 2; ++b)
#pragma unroll
                for (int m = 0; m < 4; ++m)
#pragma unroll
                    for (int n = 0; n < 2; ++n) acc[a][b][m][n] = (f32x4){0.f, 0.f, 0.f, 0.f};
        cur = nxt; cA = nA; cB = nB; ++ui;
        if constexpr (ALIGN_EPI) { if (wr == 1) PG8_BAR; }
    }
    PG8_WAIT_V(0);
    if constexpr (!ALIGN_EPI) { if (wr == 0) PG8_BAR; }
    PG8_BAR;
    if constexpr (Epi::AFTER_DRAIN) { E.fused(acc, cur, wr, wc, fr, fq, lds, wid, lane); }
#undef PG8_SA
#undef PG8_SB
#undef PG8_STAGE
#undef PG8_LDA
#undef PG8_LDB
#undef PG8_MMA
#undef PG8_WAIT_V
#undef PG8_WAIT_L
#undef PG8_BAR
#undef PG8_SCHED
}
}

constexpr int D = 1024, NTOK_P = 4 * 4096, NTOK_S = 8 * 8192, NTOK = NTOK_P + NTOK_S;
constexpr int SP = 4096, SS = 8192, FF = 2816, NCHUNK = NTOK / 128, NRU = NCHUNK * 8;
constexpr int HALF_TOK = NTOK / 2;
constexpr float NORM_EPS = 1e-6f, GN_EPS = 1e-5f;
constexpr size_t MiB = 1u << 20;
constexpr size_t WS_WQK = 1 * MiB, WS_WFV = 3 * MiB, WS_WGRET = 6 * MiB, WS_WGA = 8 * MiB, WS_WGB = 10 * MiB, WS_W4 = 12 * MiB, WS_WRET = 14 * MiB, WS_WOUT = 16 * MiB,
                 WS_WUP = 18 * MiB, WS_WDOWN = 29 * MiB, WS_TAB = 36 * MiB, WS_LG = 38 * MiB, WS_PS1 = 40 * MiB, WS_PS2 = 42 * MiB;
constexpr size_t WS_XN = 48 * MiB, WS_FV = 208 * MiB, WS_QK = 448 * MiB, WS_O = 608 * MiB, WS_DM = 768 * MiB, WS_SCR = 896 * MiB, WS_END = 960 * MiB;
constexpr size_t WS_BA = WS_FV, WS_BB = WS_QK;
constexpr size_t WS_ACT = 208 * MiB, WS_X2B = 648 * MiB;
constexpr size_t DO_AB = 0, DO_LS = 160 * MiB;
constexpr int LDS_BYTES = 147456;

#define LAS __attribute__((address_space(3)))
typedef unsigned short bf16;
typedef unsigned v4u __attribute__((ext_vector_type(4)));
typedef unsigned v2u __attribute__((ext_vector_type(2)));
typedef float f32x4 __attribute__((ext_vector_type(4)));
typedef short bf16x8 __attribute__((ext_vector_type(8)));
using pg8::cvt_pk_bf16; using pg8::bflo; using pg8::bfhi;
__device__ __forceinline__ float wave_sum(float v) {
#pragma unroll
    for (int o = 1; o < 64; o <<= 1) v += __shfl_xor(v, o);
    return v;
}
__device__ __forceinline__ float exp2_(float x) { return __builtin_amdgcn_exp2f(x); }

#define XB_TMO      128
#define XB_XCNT(j)  (256  + 64 * (j))
#define XB_XSUB(j)  (1280 + 64 * (j))
#define XB_XGEN(j)  (2304 + 64 * (j))
#define XB_TOP      3328
#define XB_TOPGEN   3392
#define XCD_BAR_WORDS 3456
#define XB_SPIN_CAP (1u << 18)

__device__ __forceinline__ unsigned xb_ld(unsigned* p)              { return __hip_atomic_load(p, __ATOMIC_RELAXED, __HIP_MEMORY_SCOPE_AGENT); }
__device__ __forceinline__ unsigned xb_add(unsigned* p, unsigned v) { return __hip_atomic_fetch_add(p, v, __ATOMIC_RELAXED, __HIP_MEMORY_SCOPE_AGENT); }
__device__ __forceinline__ unsigned xb_xcc_id() { return (unsigned)__builtin_amdgcn_s_getreg((3 << 11) | 20) & 0xFu; }
#define XB_SPIN(cond, bar) do { unsigned _sp = 0; while (cond) { __builtin_amdgcn_s_sleep(1); \
    if ((++_sp & 255u) == 0u) { if (xb_ld(&(bar)[XB_TMO])) break; if (_sp > XB_SPIN_CAP) { atomicAdd(&(bar)[XB_TMO], 1u); break; } } } } while (0)

struct XcdBarrier {
    unsigned* bar; unsigned x;
    volatile LAS unsigned* st;
};

__device__ __forceinline__ XcdBarrier xcd_barrier_post(unsigned* bar, volatile LAS unsigned* st) {
    XcdBarrier b; b.bar = bar; b.x = xb_xcc_id(); b.st = st;
    if (threadIdx.x == 0) (void)xb_add(&bar[XB_XCNT(b.x)], 1u);
    return b;
}
__device__ __forceinline__ void xcd_barrier_complete(unsigned* bar, unsigned x, unsigned& nloc, unsigned& nx) {
    const unsigned G = gridDim.x * gridDim.y * gridDim.z;
    unsigned sum, cnt, mine, sp = 0u;
    for (;;) {
        sum = 0u; cnt = 0u; mine = 0u;
#pragma unroll
        for (unsigned j = 0; j < 16; ++j) { const unsigned c = xb_ld(&bar[XB_XCNT(j)]); sum += c; cnt += (c > 0u) ? 1u : 0u; mine = (j == x) ? c : mine; }
        if (sum == G) break;
        __builtin_amdgcn_s_sleep(1);
        if ((++sp & 255u) == 0u) { if (xb_ld(&bar[XB_TMO])) break; if (sp > XB_SPIN_CAP) { atomicAdd(&bar[XB_TMO], 1u); break; } }
    }
    nloc = mine > 0u ? mine : 1u; nx = cnt > 0u ? cnt : 1u;
}

__device__ __forceinline__ void xcd_barrier(const XcdBarrier& b) {
    asm volatile("s_waitcnt vmcnt(0)" ::: "memory");
    __syncthreads();
    if (threadIdx.x == 0) {
        unsigned* bar = b.bar;
        __builtin_amdgcn_s_waitcnt(0);
        unsigned nloc = b.st[0], nx = b.st[1];
        if (nloc == 0u) { xcd_barrier_complete(bar, b.x, nloc, nx); b.st[0] = nloc; b.st[1] = nx; }
        const unsigned old = xb_add(&bar[XB_XSUB(b.x)], 1u);
        const unsigned gen = old / nloc;
        if (old + 1u == (gen + 1u) * nloc) {
            __builtin_amdgcn_fence(__ATOMIC_RELEASE, "agent");
            asm volatile("s_waitcnt vmcnt(0)" ::: "memory");
            const unsigned og = xb_add(&bar[XB_TOP], 1u);
            const unsigned tg = og / nx;
            if (og + 1u == (tg + 1u) * nx) xb_add(&bar[XB_TOPGEN], 1u);
            else XB_SPIN(xb_ld(&bar[XB_TOPGEN]) == tg, bar);
            __builtin_amdgcn_fence(__ATOMIC_ACQUIRE, "agent");
            xb_add(&bar[XB_XGEN(b.x)], 1u);
            asm volatile("s_waitcnt vmcnt(0)" ::: "memory");
        } else {
            XB_SPIN(xb_ld(&bar[XB_XGEN(b.x)]) == gen, bar);
            __builtin_amdgcn_fence(__ATOMIC_ACQUIRE, "agent");
            asm volatile("s_waitcnt vmcnt(0)" ::: "memory");
        }
    }
    __syncthreads();
}

#define LBAR() do { asm volatile("s_waitcnt lgkmcnt(0)" ::: "memory"); __builtin_amdgcn_s_barrier(); asm volatile("" ::: "memory"); } while (0)
struct Ctx { LAS unsigned char* lds; int tid, lane, wave, gw, NGW, gtid, NT; };

template <int MODE> __device__ __forceinline__ int rowmap(int n) {
    if (MODE == 1) { const int d = n & 63, p = d & 31; return (n & ~63) | ((p >> 2) << 3) | ((d >> 5) << 2) | (p & 3); }
    if (MODE == 2) { return n < FF ? 256 * (n / 128) + (n % 128) : 256 * ((n - FF) / 128) + 128 + ((n - FF) % 128); }
    return n;
}
template <int MODE> __device__ __forceinline__ void transpose_mat(const Ctx& C, const float* W, int Ksrc, int ldw, int col0, int ncols, bf16* WT, const float* kscale = nullptr, float sscale = 1.0f) {
    LAS float* scr = (LAS float*)(C.lds + C.wave * 16384);
    const int nblk = ncols / 32, nitems = (Ksrc / 64) * nblk, lane = C.lane;
    for (int it = C.gw; it < nitems; it += C.NGW) {
        const int kb = it / nblk, nb = it % nblk, k0 = 64 * kb, n0 = 32 * nb;
#pragma unroll 8
        for (int i = 0; i < 32; ++i) { const int kk = 2 * i + (lane >> 5); scr[kk * 33 + (lane & 31)] = W[(size_t)(k0 + kk) * ldw + col0 + n0 + (lane & 31)] * (kscale ? kscale[k0 + kk] * sscale : sscale); }
        asm volatile("s_waitcnt lgkmcnt(0)" ::: "memory");
        const int c = lane & 7;
#pragma unroll
        for (int j = 0; j < 4; ++j) { const int n = (lane >> 3) + 8 * j; const LAS float* s = scr + (8 * c) * 33 + n;
            v4u o; o.x = cvt_pk_bf16(s[0 * 33], s[1 * 33]); o.y = cvt_pk_bf16(s[2 * 33], s[3 * 33]); o.z = cvt_pk_bf16(s[4 * 33], s[5 * 33]); o.w = cvt_pk_bf16(s[6 * 33], s[7 * 33]);
            *(v4u*)(WT + (size_t)rowmap<MODE>(n0 + n) * Ksrc + k0 + 8 * c) = o; }
        asm volatile("s_waitcnt lgkmcnt(0)" ::: "memory");
    }
}
__device__ __forceinline__ void rms_row_to_bf16(int lane, const float* xrow, const float* g, bf16* orow) {
    const f32x4* xr = (const f32x4*)xrow + lane; const f32x4* gr = (const f32x4*)g + lane;
    f32x4 v[4]; float s = 0.f;
#pragma unroll
    for (int j = 0; j < 4; ++j) { v[j] = xr[64 * j]; s += (v[j].x * v[j].x + v[j].y * v[j].y) + (v[j].z * v[j].z + v[j].w * v[j].w); }
    const float r = 1.0f / sqrtf(wave_sum(s) * (1.f / D) + NORM_EPS);
    v2u* o8 = (v2u*)orow + lane;
#pragma unroll
    for (int j = 0; j < 4; ++j) { const f32x4 gg = gr[64 * j]; v2u w; w.x = cvt_pk_bf16(v[j].x * r * gg.x, v[j].y * r * gg.y); w.y = cvt_pk_bf16(v[j].z * r * gg.z, v[j].w * r * gg.w); o8[64 * j] = w; }
}
__device__ __forceinline__ void rms_row2_to_bf16(int lane, const float* xa, const float* xb, const float* g, bf16* oa, bf16* ob) {
    const f32x4* pa = (const f32x4*)xa + lane; const f32x4* pb = (const f32x4*)xb + lane; const f32x4* gr = (const f32x4*)g + lane;
    f32x4 va[4], vb[4]; float sa = 0.f, sb = 0.f;
#pragma unroll
    for (int j = 0; j < 4; ++j) { va[j] = pa[64 * j]; vb[j] = pb[64 * j]; }
#pragma unroll
    for (int j = 0; j < 4; ++j) { sa += (va[j].x * va[j].x + va[j].y * va[j].y) + (va[j].z * va[j].z + va[j].w * va[j].w); sb += (vb[j].x * vb[j].x + vb[j].y * vb[j].y) + (vb[j].z * vb[j].z + vb[j].w * vb[j].w); }
    const float ra = 1.0f / sqrtf(wave_sum(sa) * (1.f / D) + NORM_EPS), rb = 1.0f / sqrtf(wave_sum(sb) * (1.f / D) + NORM_EPS);
    v2u* o8a = (v2u*)oa + lane; v2u* o8b = (v2u*)ob + lane;
#pragma unroll
    for (int j = 0; j < 4; ++j) { const f32x4 gg = gr[64 * j]; v2u w; w.x = cvt_pk_bf16(va[j].x * ra * gg.x, va[j].y * ra * gg.y); w.y = cvt_pk_bf16(va[j].z * ra * gg.z, va[j].w * ra * gg.w); o8a[64 * j] = w;
        v2u z; z.x = cvt_pk_bf16(vb[j].x * rb * gg.x, vb[j].y * rb * gg.y); z.y = cvt_pk_bf16(vb[j].z * rb * gg.z, vb[j].w * rb * gg.w); o8b[64 * j] = z; }
}
__device__ __forceinline__ void rms_row_f32(int lane, float* xrow, const float* g) {
    f32x4* xr = (f32x4*)xrow + lane; const f32x4* gr = (const f32x4*)g + lane;
    f32x4 v[4]; float s = 0.f;
#pragma unroll
    for (int j = 0; j < 4; ++j) { v[j] = xr[64 * j]; s += (v[j].x * v[j].x + v[j].y * v[j].y) + (v[j].z * v[j].z + v[j].w * v[j].w); }
    const float r = 1.0f / sqrtf(wave_sum(s) * (1.f / D) + NORM_EPS);
#pragma unroll
    for (int j = 0; j < 4; ++j) { const f32x4 gg = gr[64 * j]; xr[64 * j] = v[j] * r * gg; }
}

__device__ __forceinline__ void fold_w4(const Ctx& C, const float* Wp, bf16* W4T) {
    LAS float* tw = (LAS float*)(C.lds + 131072);
    if (C.tid < 128) { const float x = (float)C.tid * (1.0f / 128.0f); tw[C.tid] = __builtin_amdgcn_cosf(x); tw[128 + C.tid] = -__builtin_amdgcn_sinf(x); }
    __syncthreads();
    for (int item = C.gtid; item < 1024 * 128; item += C.NT) {
        const int o = item & 1023, rest = item >> 10, g = rest >> 5, part = (rest >> 4) & 1, c0 = (rest & 15) * 8;
        const float* wp = Wp + (size_t)(g * 128) * 1024 + o; const LAS float* tb = tw + part * 128; float s[8]; int idx[8];
#pragma unroll
        for (int i = 0; i < 8; ++i) { s[i] = 0.f; idx[i] = 0; }
#pragma unroll 16
        for (int c2 = 0; c2 < 128; ++c2) { const float w = wp[(size_t)c2 * 1024];
#pragma unroll
            for (int i = 0; i < 8; ++i) { s[i] += tb[idx[i]] * w; idx[i] = (idx[i] + c0 + i) & 127; } }
        v4u ov; ov.x = cvt_pk_bf16(s[0], s[1]); ov.y = cvt_pk_bf16(s[2], s[3]); ov.z = cvt_pk_bf16(s[4], s[5]); ov.w = cvt_pk_bf16(s[6], s[7]);
        *(v4u*)(W4T + (size_t)o * 1024 + part * 512 + g * 128 + c0) = ov;
    }
    __syncthreads();
}
__device__ __forceinline__ void gen_dm(const Ctx& C, bf16* DM) {
    for (int idx = C.gtid; idx < 2 * 4096 * 512; idx += C.NT) {
        const int part = idx >> 21, n = (idx >> 9) & 4095, m0 = (idx & 511) * 8; float v[8];
#pragma unroll
        for (int j = 0; j < 8; ++j) { const float x = (float)((n * (m0 + j)) & 8191) * (1.0f / 8192.0f); v[j] = (part ? __builtin_amdgcn_sinf(x) : __builtin_amdgcn_cosf(x)) * (1.0f / 1024.0f); }
        v4u o; o.x = cvt_pk_bf16(v[0], v[1]); o.y = cvt_pk_bf16(v[2], v[3]); o.z = cvt_pk_bf16(v[4], v[5]); o.w = cvt_pk_bf16(v[6], v[7]);
        *(v4u*)(DM + (size_t)idx * 8) = o;
    }
}
__device__ __forceinline__ void fold_ft(const Ctx& C, bf16* FT) {
    constexpr int NCH = 512 * (NTOK / 16);
    for (int idx = C.gtid; idx < NCH; idx += C.NT) {
        const int c = idx / (NTOK / 16), q = idx % (NTOK / 16); int r0, m0, S;
        if (q < NTOK_P / 16) { S = SP; r0 = (q / (SP / 16)) * SP; m0 = (q % (SP / 16)) * 8; } else { const int q2 = q - NTOK_P / 16; S = SS; r0 = NTOK_P + (q2 / (SS / 16)) * SS; m0 = (q2 % (SS / 16)) * 8; }
        bf16* row = FT + (size_t)c * NTOK + r0;
        const v4u X = *(const v4u*)(row + m0), Z = *(const v4u*)(row + S - m0 - 8); const unsigned short p0 = (m0 > 0) ? row[S - m0] : (unsigned short)0;
        const float x[8] = {bflo(X.x), bfhi(X.x), bflo(X.y), bfhi(X.y), bflo(X.z), bfhi(X.z), bflo(X.w), bfhi(X.w)};
        const float z[8] = {bflo(Z.x), bfhi(Z.x), bflo(Z.y), bfhi(Z.y), bflo(Z.z), bfhi(Z.z), bflo(Z.w), bfhi(Z.w)};
        float xo[8], zo[8];
        const float pz = bflo((unsigned)p0);
        xo[0] = (m0 > 0) ? x[0] + pz : x[0];
#pragma unroll
        for (int t = 1; t < 8; ++t) { xo[t] = x[t] + z[8 - t]; zo[8 - t] = x[t] - z[8 - t]; }
        v4u XO; XO.x = cvt_pk_bf16(xo[0], xo[1]); XO.y = cvt_pk_bf16(xo[2], xo[3]); XO.z = cvt_pk_bf16(xo[4], xo[5]); XO.w = cvt_pk_bf16(xo[6], xo[7]);
        *(v4u*)(row + m0) = XO;
        bf16* zp = row + S - m0 - 8;
        zp[1] = (bf16)(cvt_pk_bf16(zo[1], 0.f) & 0xffffu); *(unsigned*)(zp + 2) = cvt_pk_bf16(zo[2], zo[3]); { v2u w; w.x = cvt_pk_bf16(zo[4], zo[5]); w.y = cvt_pk_bf16(zo[6], zo[7]); *(v2u*)(zp + 4) = w; }
        if (m0 > 0) row[S - m0] = (bf16)(cvt_pk_bf16(x[0] - pz, 0.f) & 0xffffu);
    }
}
__device__ __forceinline__ void gen_tab(const Ctx& C, float* tab, const float* decay_logit, float* lg2) {
    for (int idx = C.gtid; idx < 8192 * 32; idx += C.NT) {
        const int pos = idx >> 5, p = idx & 31;
        const double inv = exp(-(double)p * (9.210340371976184 / 32.0));
        double t = (double)pos * inv * 0.15915494309189535; t -= floor(t);
        const float x = (float)t; tab[2 * idx] = __builtin_amdgcn_cosf(x); tab[2 * idx + 1] = __builtin_amdgcn_sinf(x);
    }
    if (C.gtid < 16) { const float x = decay_logit[C.gtid]; const float ls = -log1pf(expf(-x)); lg2[C.gtid] = ls * 1.4426950408889634f; }
}
__device__ __forceinline__ void r1_phase(const Ctx& C, const bf16* QK, const bf16* VT, bf16* LS, const float* lg2) {
    const int tid = C.tid, w = C.wave, lane = C.lane, fr = lane & 15, fq = lane >> 4;
    LAS unsigned char* KT = C.lds;
    LAS float* LGL = (LAS float*)(C.lds + 128 * 272);
    if (tid < 16) LGL[tid] = lg2[tid];
    __syncthreads();
    int u = blockIdx.x; if (u >= NRU) return;
    const int e = 16 * w + fr; v4u kv[2]; bf16x8 va[4];
#pragma unroll
    for (int i = 0; i < 2; ++i) { const int q = tid + 512 * i; kv[i] = *(const v4u*)(QK + ((size_t)(NRU + u) * 128 + (q >> 3)) * 64 + (q & 7) * 8); }
#pragma unroll
    for (int ks = 0; ks < 4; ++ks) va[ks] = *(const bf16x8*)(VT + ((size_t)u * 128 + e) * 128 + ks * 32 + fq * 8);
    for (; u < NRU; u += gridDim.x) {
        const int h = u & 7; const float lf = LGL[h], lb = LGL[8 + h];
#pragma unroll
        for (int i = 0; i < 2; ++i) { const int q = tid + 512 * i, ap = q >> 3, dg = q & 7;
            const float sf = exp2_(lf * (float)(127 - ap)), sb = exp2_(lb * (float)ap);
            const float kf[8] = {bflo(kv[i].x), bfhi(kv[i].x), bflo(kv[i].y), bfhi(kv[i].y), bflo(kv[i].z), bfhi(kv[i].z), bflo(kv[i].w), bfhi(kv[i].w)};
#pragma unroll
            for (int j = 0; j < 8; ++j) { const int d = dg * 8 + j;
                *(LAS bf16*)(KT + d * 272 + ap * 2) = (bf16)(cvt_pk_bf16(kf[j] * sf, 0.f) & 0xffffu);
                *(LAS bf16*)(KT + (64 + d) * 272 + ap * 2) = (bf16)(cvt_pk_bf16(kf[j] * sb, 0.f) & 0xffffu); } }
        bf16x8 vc[4];
#pragma unroll
        for (int ks = 0; ks < 4; ++ks) vc[ks] = va[ks];
        LBAR();
        { const int un = u + gridDim.x, unx = un < NRU ? un : u;
#pragma unroll
          for (int i = 0; i < 2; ++i) { const int q = tid + 512 * i; kv[i] = *(const v4u*)(QK + ((size_t)(NRU + unx) * 128 + (q >> 3)) * 64 + (q & 7) * 8); }
#pragma unroll
          for (int ks = 0; ks < 4; ++ks) va[ks] = *(const bf16x8*)(VT + ((size_t)unx * 128 + e) * 128 + ks * 32 + fq * 8); }
        f32x4 acc[8];
#pragma unroll
        for (int c2 = 0; c2 < 8; c2 += 2) { bf16x8 kb[2][4];
#pragma unroll
            for (int cc = 0; cc < 2; ++cc)
#pragma unroll
                for (int ks = 0; ks < 4; ++ks) kb[cc][ks] = *(const LAS bf16x8*)(KT + (16 * (c2 + cc) + fr) * 272 + ks * 64 + fq * 16);
            __builtin_amdgcn_sched_barrier(0);
            f32x4 a0 = (f32x4){0.f, 0.f, 0.f, 0.f}, a1 = (f32x4){0.f, 0.f, 0.f, 0.f};
#pragma unroll
            for (int ks = 0; ks < 4; ++ks) { a0 = __builtin_amdgcn_mfma_f32_16x16x32_bf16(kb[0][ks], vc[ks], a0, 0, 0, 0); a1 = __builtin_amdgcn_mfma_f32_16x16x32_bf16(kb[1][ks], vc[ks], a1, 0, 0, 0); }
            acc[c2] = a0; acc[c2 + 1] = a1;
            __builtin_amdgcn_sched_barrier(0); }
        bf16* op = LS + ((size_t)u * 128 + e) * 128 + 4 * fq;
#pragma unroll
        for (int ct = 0; ct < 8; ++ct) { v2u wv; wv.x = cvt_pk_bf16(acc[ct][0], acc[ct][1]); wv.y = cvt_pk_bf16(acc[ct][2], acc[ct][3]); *(v2u*)(op + 16 * ct) = wv; }
        LBAR();
    }
}
struct ScanItem { bf16* base; int nch, ck0, dir; float dec; };
__device__ __forceinline__ ScanItem scan_item(int it, bf16* LS, const float* lg2) {
    const int ddg = it & 15, e = (it >> 4) & 127, h = (it >> 11) & 7, sq = it >> 14; ScanItem s;
    s.nch = sq < 4 ? 32 : 64; s.ck0 = sq < 4 ? sq * 32 : 128 + (sq - 4) * 64; s.dir = ddg >> 3;
    s.dec = exp2_(128.0f * lg2[s.dir * 8 + h]); s.base = LS + ((size_t)h * 128 + e) * 128 + ddg * 8; return s;
}
__device__ __forceinline__ void scan_step(const ScanItem& I, int i, const v4u ld, float (&s)[8]) {
    const int ck = I.ck0 + (I.dir ? I.nch - 1 - i : i);
    v4u o; o.x = cvt_pk_bf16(s[0], s[1]); o.y = cvt_pk_bf16(s[2], s[3]); o.z = cvt_pk_bf16(s[4], s[5]); o.w = cvt_pk_bf16(s[6], s[7]);
    *(v4u*)(I.base + (size_t)ck * 131072) = o;
    const float l[8] = {bflo(ld.x), bfhi(ld.x), bflo(ld.y), bfhi(ld.y), bflo(ld.z), bfhi(ld.z), bflo(ld.w), bfhi(ld.w)};
#pragma unroll
    for (int j = 0; j < 8; ++j) s[j] = s[j] * I.dec + l[j];
}
__device__ __forceinline__ void r2_phase(const Ctx& C, bf16* LS, const float* lg2) {
    constexpr int NIT = 12 * 8 * 128 * 16, NA = 131072;
    for (int t0 = C.gtid; t0 < NA; t0 += C.NT) {
        const bool hasB = t0 + NA < NIT;
        const ScanItem A = scan_item(t0, LS, lg2), B = scan_item(hasB ? t0 + NA : t0, LS, lg2);
        float sA[8], sB[8];
#pragma unroll
        for (int j = 0; j < 8; ++j) { sA[j] = 0.f; sB[j] = 0.f; }
        const int nmax = hasB ? (A.nch > B.nch ? A.nch : B.nch) : A.nch;
        for (int i0 = 0; i0 < nmax; i0 += 8) {
            const bool actA = i0 < A.nch, actB = hasB && i0 < B.nch;
            v4u ldA[8], ldB[8];
#pragma unroll
            for (int k = 0; k < 8; ++k) { const int i = i0 + k;
                ldA[k] = actA ? *(const v4u*)(A.base + (size_t)(A.ck0 + (A.dir ? A.nch - 1 - i : i)) * 131072) : (v4u){0u, 0u, 0u, 0u};
                ldB[k] = actB ? *(const v4u*)(B.base + (size_t)(B.ck0 + (B.dir ? B.nch - 1 - i : i)) * 131072) : (v4u){0u, 0u, 0u, 0u}; }
#pragma unroll
            for (int k = 0; k < 8; ++k) { if (actA) scan_step(A, i0 + k, ldA[k], sA); if (actB) scan_step(B, i0 + k, ldB[k], sB); }
        }
    }
}
struct R3Loads { bf16x8 qa[2], kb[8][2], bfr[8]; };
__device__ __forceinline__ void r3_issue_qk(R3Loads& L, const bf16* QK, int u, int w, int fr, int fq) {
#pragma unroll
    for (int ks = 0; ks < 2; ++ks) L.qa[ks] = *(const bf16x8*)(QK + ((size_t)u * 128 + 16 * w + fr) * 64 + ks * 32 + fq * 8);
#pragma unroll
    for (int ct = 0; ct < 8; ++ct)
#pragma unroll
        for (int ks = 0; ks < 2; ++ks) L.kb[ct][ks] = *(const bf16x8*)(QK + ((size_t)(NRU + u) * 128 + 16 * ct + fr) * 64 + ks * 32 + fq * 8);
}
__device__ __forceinline__ void r3_issue_b(R3Loads& L, const bf16* VT, const bf16* LS, int u, int w, int fr, int fq) {
#pragma unroll
    for (int ks = 0; ks < 4; ++ks) L.bfr[ks] = *(const bf16x8*)(VT + ((size_t)u * 128 + 16 * w + fr) * 128 + ks * 32 + fq * 8);
#pragma unroll
    for (int ks = 0; ks < 4; ++ks) L.bfr[4 + ks] = *(const bf16x8*)(LS + ((size_t)u * 128 + 16 * w + fr) * 128 + ks * 32 + fq * 8);
}
__device__ __forceinline__ void r3_phase(const Ctx& C, const bf16* QK, const bf16* VT, const bf16* LS, bf16* O, const float* lg2) {
    const int w = C.wave, lane = C.lane, fr = lane & 15, fq = lane >> 4;
    LAS unsigned char* A2 = C.lds; LAS float* RED = (LAS float*)(C.lds + 128 * 528);
    LAS float* LGL = (LAS float*)(C.lds + 128 * 528 + 8192);
    if (C.tid < 16) LGL[C.tid] = lg2[C.tid];
    __syncthreads();
    int u = blockIdx.x; if (u >= NRU) return;
    R3Loads cur; r3_issue_qk(cur, QK, u, w, fr, fq); r3_issue_b(cur, VT, LS, u, w, fr, fq);
    for (; u < NRU; u += gridDim.x) {
        const int ck = u >> 3, h = u & 7; const size_t t0 = (size_t)ck * 128; const float lf = LGL[h], lb = LGL[8 + h];
        const int a = 16 * w + fr;
#pragma unroll
        for (int ct = 0; ct < 8; ++ct) { f32x4 sc = (f32x4){0.f, 0.f, 0.f, 0.f};
#pragma unroll
            for (int ks = 0; ks < 2; ++ks) sc = __builtin_amdgcn_mfma_f32_16x16x32_bf16(cur.kb[ct][ks], cur.qa[ks], sc, 0, 0, 0);
            float p[4];
#pragma unroll
            for (int j = 0; j < 4; ++j) { const int df = a - (16 * ct + 4 * fq + j); const float dcy = df >= 0 ? exp2_(lf * (float)df) : exp2_(lb * (float)(-df)); p[j] = sc[j] * dcy; }
            v2u wv; wv.x = cvt_pk_bf16(p[0], p[1]); wv.y = cvt_pk_bf16(p[2], p[3]); *(LAS v2u*)(A2 + a * 528 + (16 * ct + 4 * fq) * 2) = wv; }
        { const float gf = exp2_(lf * (float)(a + 1)), gb = exp2_(lb * (float)(128 - a));
#pragma unroll
          for (int ks = 0; ks < 2; ++ks) { const v4u qv = __builtin_bit_cast(v4u, cur.qa[ks]);
              const float qf[8] = {bflo(qv.x), bfhi(qv.x), bflo(qv.y), bfhi(qv.y), bflo(qv.z), bfhi(qv.z), bflo(qv.w), bfhi(qv.w)};
              v4u f, b; f.x = cvt_pk_bf16(qf[0] * gf, qf[1] * gf); f.y = cvt_pk_bf16(qf[2] * gf, qf[3] * gf); f.z = cvt_pk_bf16(qf[4] * gf, qf[5] * gf); f.w = cvt_pk_bf16(qf[6] * gf, qf[7] * gf);
              b.x = cvt_pk_bf16(qf[0] * gb, qf[1] * gb); b.y = cvt_pk_bf16(qf[2] * gb, qf[3] * gb); b.z = cvt_pk_bf16(qf[4] * gb, qf[5] * gb); b.w = cvt_pk_bf16(qf[6] * gb, qf[7] * gb);
              *(LAS v4u*)(A2 + a * 528 + (128 + ks * 32 + fq * 8) * 2) = f; *(LAS v4u*)(A2 + a * 528 + (192 + ks * 32 + fq * 8) * 2) = b; } }
        LBAR();
        const int un = u + gridDim.x, unx = un < NRU ? un : u;
        r3_issue_qk(cur, QK, unx, w, fr, fq);
        f32x4 oc[8];
#pragma unroll
        for (int rt = 0; rt < 8; ++rt) { oc[rt] = (f32x4){0.f, 0.f, 0.f, 0.f};
#pragma unroll
            for (int ks = 0; ks < 8; ++ks) { const bf16x8 af = *(const LAS bf16x8*)(A2 + (16 * rt + fr) * 528 + ks * 64 + fq * 16); oc[rt] = __builtin_amdgcn_mfma_f32_16x16x32_bf16(cur.bfr[ks], af, oc[rt], 0, 0, 0); } }
        r3_issue_b(cur, VT, LS, unx, w, fr, fq);
#pragma unroll
        for (int rt = 0; rt < 8; ++rt) { float s1 = (oc[rt][0] + oc[rt][1]) + (oc[rt][2] + oc[rt][3]), s2 = (oc[rt][0] * oc[rt][0] + oc[rt][1] * oc[rt][1]) + (oc[rt][2] * oc[rt][2] + oc[rt][3] * oc[rt][3]);
            s1 += __shfl_xor(s1, 16); s1 += __shfl_xor(s1, 32); s2 += __shfl_xor(s2, 16); s2 += __shfl_xor(s2, 32);
            if (fq == 0) { RED[(16 * rt + fr) * 8 + w] = s1; RED[1024 + (16 * rt + fr) * 8 + w] = s2; } }
        LBAR();
        bf16* op = O + (t0 + fr) * 1024 + h * 128 + 16 * w + 4 * fq;
#pragma unroll
        for (int rt = 0; rt < 8; ++rt) { const LAS float* rp = RED + (16 * rt + fr) * 8;
            const f32x4 x0 = *(const LAS f32x4*)rp, x1 = *(const LAS f32x4*)(rp + 4), y0 = *(const LAS f32x4*)(rp + 1024), y1 = *(const LAS f32x4*)(rp + 1028);
            const float S1 = ((x0[0] + x0[1]) + (x0[2] + x0[3])) + ((x1[0] + x1[1]) + (x1[2] + x1[3])), S2 = ((y0[0] + y0[1]) + (y0[2] + y0[3])) + ((y1[0] + y1[1]) + (y1[2] + y1[3]));
            const float mu = S1 * (1.f / 128.f), var = fmaxf(S2 * (1.f / 128.f) - mu * mu, 0.f), rs = __builtin_amdgcn_rsqf(var + GN_EPS);
            v2u wv; wv.x = cvt_pk_bf16((oc[rt][0] - mu) * rs, (oc[rt][1] - mu) * rs); wv.y = cvt_pk_bf16((oc[rt][2] - mu) * rs, (oc[rt][3] - mu) * rs);
            *(v2u*)(op + (size_t)(16 * rt) * 1024) = wv; }
        LBAR();
    }
}
__device__ __forceinline__ void dft_nyquist(const Ctx& C, const bf16* FT, bf16* AB) {
    for (int it = C.gw; it < 12 * 512; it += C.NGW) {
        const int sq = it >> 9, c = it & 511, S = sq < 4 ? SP : SS, r0 = sq < 4 ? sq * SP : NTOK_P + (sq - 4) * SS;
        const bf16* src = FT + (size_t)c * NTOK + r0; float s = 0.f;
        for (int m0 = C.lane * 8; m0 < S / 2; m0 += 2048) { v4u v[4];
#pragma unroll
            for (int k = 0; k < 4; ++k) v[k] = *(const v4u*)(src + m0 + 512 * k);
#pragma unroll
            for (int k = 0; k < 4; ++k) s += (bflo(v[k].x) - bfhi(v[k].x)) + (bflo(v[k].y) - bfhi(v[k].y)) + (bflo(v[k].z) - bfhi(v[k].z)) + (bflo(v[k].w) - bfhi(v[k].w)); }
        s = (wave_sum(s) + bflo((unsigned)src[S / 2])) * (sq < 4 ? 0.001381067932f : 0.0009765625f);
        if (C.lane == 0) { AB[(size_t)(r0 + S / 2) * 1024 + c] = (bf16)(cvt_pk_bf16(s, 0.f) & 0xffffu); AB[(size_t)(r0 + S / 2) * 1024 + 512 + c] = 0; }
    }
}
__device__ __forceinline__ void conv_act(const Ctx& C, const bf16* H, bf16* ACT, const float* cw, const float* cb, int half) {
    for (int idx = C.gtid; idx < HALF_TOK * (FF / 8); idx += C.NT) {
        const int tl = idx / (FF / 8), ch0 = (idx % (FF / 8)) * 8, t = half * HALF_TOK + tl;
        const int S = t < NTOK_P ? SP : SS, pos = t & (S - 1), hc = 256 * (ch0 >> 7) + (ch0 & 127);
        const bf16* hr = H + (size_t)tl * (2 * FF) + hc;
        const v4u g1 = *(const v4u*)hr, vv = *(const v4u*)(hr + 128); v4u g0 = (v4u){0u, 0u, 0u, 0u}, g2 = (v4u){0u, 0u, 0u, 0u};
        if (pos > 0) g0 = *(const v4u*)(hr - 2 * FF);
        if (pos < S - 1) g2 = *(const v4u*)(hr + 2 * FF);
        const float a0[8] = {bflo(g0.x), bfhi(g0.x), bflo(g0.y), bfhi(g0.y), bflo(g0.z), bfhi(g0.z), bflo(g0.w), bfhi(g0.w)};
        const float a1[8] = {bflo(g1.x), bfhi(g1.x), bflo(g1.y), bfhi(g1.y), bflo(g1.z), bfhi(g1.z), bflo(g1.w), bfhi(g1.w)};
        const float a2[8] = {bflo(g2.x), bfhi(g2.x), bflo(g2.y), bfhi(g2.y), bflo(g2.z), bfhi(g2.z), bflo(g2.w), bfhi(g2.w)};
        const float av[8] = {bflo(vv.x), bfhi(vv.x), bflo(vv.y), bfhi(vv.y), bflo(vv.z), bfhi(vv.z), bflo(vv.w), bfhi(vv.w)};
        float r[8];
#pragma unroll
        for (int j = 0; j < 8; ++j) { const float x = cw[ch0 + j] * a0[j] + cw[FF + ch0 + j] * a1[j] + cw[2 * FF + ch0 + j] * a2[j] + cb[ch0 + j];
            r[j] = 0.5f * x * (1.0f + erff(x * 0.70710678118654752f)) * av[j]; }
        v4u o; o.x = cvt_pk_bf16(r[0], r[1]); o.y = cvt_pk_bf16(r[2], r[3]); o.z = cvt_pk_bf16(r[4], r[5]); o.w = cvt_pk_bf16(r[6], r[7]);
        *(v4u*)(ACT + (size_t)tl * FF + ch0) = o;
    }
}

__device__ __forceinline__ void dbg_dump(const Ctx& C, float* out, const bf16* X, const bf16* Y) {
    for (size_t j = C.gtid; j < (size_t)NTOK * D; j += C.NT) { float v = __uint_as_float((unsigned)X[j] << 16); if (Y) v += __uint_as_float((unsigned)Y[j] << 16); out[j] = v; }
}
__device__ __forceinline__ void final_rows(const Ctx& C, const bf16* X2B, const float* PS2, const float* g, float* out) {
    const int lane = C.lane; f32x4 gg[4];
#pragma unroll
    for (int k = 0; k < 2; ++k) { gg[2 * k] = *(const f32x4*)(g + k * 512 + lane * 8); gg[2 * k + 1] = *(const f32x4*)(g + k * 512 + lane * 8 + 4); }
    for (int m = C.gw; m < NTOK; m += 2 * C.NGW) {
        const int m2 = m + C.NGW; const bool has2 = m2 < NTOK; const int mb = has2 ? m2 : m;
        const v4u a0 = *(const v4u*)(X2B + (size_t)m * D + lane * 8), a1 = *(const v4u*)(X2B + (size_t)m * D + 512 + lane * 8);
        const v4u b0 = *(const v4u*)(X2B + (size_t)mb * D + lane * 8), b1 = *(const v4u*)(X2B + (size_t)mb * D + 512 + lane * 8);
        const f32x4 pa = *(const f32x4*)(PS2 + (size_t)m * 4), pb = *(const f32x4*)(PS2 + (size_t)mb * 4);
        const float ra = 1.0f / sqrtf(((pa[0] + pa[1]) + (pa[2] + pa[3])) * (1.f / D) + NORM_EPS), rb = 1.0f / sqrtf(((pb[0] + pb[1]) + (pb[2] + pb[3])) * (1.f / D) + NORM_EPS);
        float* oa = out + (size_t)m * D + lane * 8; float* ob = out + (size_t)mb * D + lane * 8;
        *(f32x4*)(oa) = (f32x4){bflo(a0.x), bfhi(a0.x), bflo(a0.y), bfhi(a0.y)} * ra * gg[0]; *(f32x4*)(oa + 4) = (f32x4){bflo(a0.z), bfhi(a0.z), bflo(a0.w), bfhi(a0.w)} * ra * gg[1];
        *(f32x4*)(oa + 512) = (f32x4){bflo(a1.x), bfhi(a1.x), bflo(a1.y), bfhi(a1.y)} * ra * gg[2]; *(f32x4*)(oa + 516) = (f32x4){bflo(a1.z), bfhi(a1.z), bflo(a1.w), bfhi(a1.w)} * ra * gg[3];
        if (has2) {
        *(f32x4*)(ob) = (f32x4){bflo(b0.x), bfhi(b0.x), bflo(b0.y), bfhi(b0.y)} * rb * gg[0]; *(f32x4*)(ob + 4) = (f32x4){bflo(b0.z), bfhi(b0.z), bflo(b0.w), bfhi(b0.w)} * rb * gg[1];
        *(f32x4*)(ob + 512) = (f32x4){bflo(b1.x), bfhi(b1.x), bflo(b1.y), bfhi(b1.y)} * rb * gg[2]; *(f32x4*)(ob + 516) = (f32x4){bflo(b1.z), bfhi(b1.z), bflo(b1.w), bfhi(b1.w)} * rb * gg[3]; }
    }
}
struct SchedG {
    pg8::StaticOrder so; const char* A; const char* B; size_t tsa, tsb; int pm_off;
    __device__ __forceinline__ bool next(int i, pg8::Unit& u) const { if (!so.next(i, u)) return false; u.pa = A + (size_t)u.pm * tsa; u.pb = B + (size_t)u.pn * tsb; u.pm += pm_off; u.r0 = 0; u.c0 = 0; u.aux = 0; u.S = 0; return true; }
};
struct SchedDFT {
    pg8::StaticOrder so; const char* DM; const char* FT; int ntile, S, tok0; size_t lda_b;
    __device__ __forceinline__ bool next(int i, pg8::Unit& u) const {
        if (!so.next(i, u)) return false;
        const int part = u.pm / ntile, nt = u.pm % ntile, sq = u.pn >> 1, hf = u.pn & 1;
        u.pa = DM + (size_t)part * ((size_t)4096 * 4096 * 2) + (size_t)nt * 256 * lda_b;
        u.pb = FT + ((size_t)(hf * 256) * NTOK + (size_t)(tok0 + sq * S + part * (S >> 1))) * 2;
        u.pm = nt; u.r0 = tok0 + sq * S; u.c0 = part * 512 + hf * 256; u.aux = part; u.S = S; return true;
    }
};

struct SchedChain {
    pg8::StaticOrder so; const char* AB; const char* ws;
    __device__ __forceinline__ bool next(int i, pg8::Unit& u) const {
        const int st = i & 3; if (!so.next(i >> 2, u)) return false;
        const size_t offA = (st == 2) ? WS_O : WS_XN;
        const size_t offB = WS_W4 - (size_t)(st == 1) * (4 * MiB) + (size_t)(st == 2) * (2 * MiB) - (size_t)(st == 3) * (2 * MiB);
        const char* A = ws + offA; if (st == 0) A = AB;
        u.pa = A + (size_t)u.pm * ((size_t)256 * 1024 * 2); u.pb = ws + offB + (size_t)u.pn * ((size_t)256 * 1024 * 2); u.aux = st; u.r0 = 0; u.c0 = 0; u.S = 0; return true;
    }
};
struct SchedUp {
    pg8::StaticOrder so; const char* XN2; const char* W;
    __device__ __forceinline__ bool next(int i, pg8::Unit& u) const {
        if (!so.next(i, u)) return false;
        u.c0 = 254 * u.pm - 1; u.r0 = 0; u.S = 0; u.aux = 0;
        u.pa = XN2 + ((long)u.c0) * 2048; u.pb = W + (size_t)u.pn * ((size_t)256 * 1024 * 2); return true;
    }
};

constexpr int NPHASE = 11;
struct Args { const float* in[14]; float* out; unsigned char* ws; int ph_lo, ph_hi; };
__global__ void __launch_bounds__(512, 2) fwd_kernel(Args args) {
    extern __shared__ __attribute__((aligned(16))) unsigned char lds_raw[];
    Ctx C; C.lds = (LAS unsigned char*)lds_raw; C.tid = threadIdx.x; C.lane = C.tid & 63; C.wave = __builtin_amdgcn_readfirstlane(C.tid >> 6);
    C.gw = blockIdx.x * 8 + C.wave; C.NGW = gridDim.x * 8; C.gtid = blockIdx.x * 512 + C.tid; C.NT = gridDim.x * 512;
    const int G = gridDim.x, bx = blockIdx.x;
    unsigned char* ws = args.ws;
    const float* x_p = args.in[0]; const float* x_s = args.in[1]; const float* norm1_g = args.in[2]; const float* w_in = args.in[3]; const float* w_four = args.in[4];
    const float* w_ret = args.in[5]; const float* w_out = args.in[6]; const float* decay_logit = args.in[7]; const float* norm2_g = args.in[8]; const float* w_up = args.in[9];
    const float* conv_w = args.in[10]; const float* conv_b = args.in[11]; const float* w_down = args.in[12]; const float* final_g = args.in[13];
    float* out = args.out;
    bf16* WQK = (bf16*)(ws + WS_WQK); bf16* WFV = (bf16*)(ws + WS_WFV); bf16* WGRET = (bf16*)(ws + WS_WGRET); bf16* WGA = (bf16*)(ws + WS_WGA); bf16* WGB = (bf16*)(ws + WS_WGB);
    bf16* W4 = (bf16*)(ws + WS_W4); bf16* WRET = (bf16*)(ws + WS_WRET); bf16* WOUT = (bf16*)(ws + WS_WOUT); bf16* WUP = (bf16*)(ws + WS_WUP); bf16* WDOWN = (bf16*)(ws + WS_WDOWN);
    float* TAB = (float*)(ws + WS_TAB); float* LG = (float*)(ws + WS_LG);
    bf16* XN = (bf16*)(ws + WS_XN); bf16* FV = (bf16*)(ws + WS_FV); bf16* QK = (bf16*)(ws + WS_QK); bf16* OB = (bf16*)(ws + WS_O); bf16* DM = (bf16*)(ws + WS_DM);
    bf16* BA = (bf16*)(ws + WS_BA); bf16* BB = (bf16*)(ws + WS_BB); bf16* ACT = (bf16*)(ws + WS_ACT); bf16* X2B = (bf16*)(ws + WS_X2B); float* PS1 = (float*)(ws + WS_PS1); float* PS2 = (float*)(ws + WS_PS2);
    bf16* AB = (bf16*)((unsigned char*)out + DO_AB);
#ifdef DBG_LS_IN_WS
    bf16* LS = (bf16*)(ws + WS_O);
#else
    bf16* LS = (bf16*)((unsigned char*)out + DO_LS);
#endif
    const bf16* VT = FV + (size_t)512 * NTOK;
    const int lo = args.ph_lo, hi = args.ph_hi;
    volatile LAS unsigned* XST = (volatile LAS unsigned*)(C.lds + LDS_BYTES - 16);
    if (C.tid < 2) XST[C.tid] = 0u;
    __syncthreads();
    XcdBarrier xbar; xbar.bar = (unsigned*)ws; xbar.x = 0; xbar.st = XST;
    if (lo == 0 && hi == NPHASE) xbar = xcd_barrier_post((unsigned*)ws, XST);
#ifdef DBG_STOP
    if (lo == 100) { dbg_dump(C, out, (const bf16*)(ws + DBG_X), DBG_Y ? (const bf16*)(ws + DBG_Y) : (const bf16*)nullptr); return; }
#endif
#define IN(k) (lo <= (k) && (k) < hi)
#define SEAM(k) do { if (IN(k) && IN((k) + 1)) { if (hi > NPHASE) cg::this_grid().sync(); else xcd_barrier(xbar); } } while (0)
#define GEMM_CALL(EPI, SCH, g, S, E) pg8::gemm_phase<EPI, SCH, true, true>(C.lds, g, S, E)
    const size_t T1K = (size_t)256 * 1024 * 2;

    if (IN(0)) {
        transpose_mat<1>(C, w_in, 1024, 5632, 512, 512, WQK, nullptr, 0.125f);
        transpose_mat<1>(C, w_in, 1024, 5632, 1024, 512, WQK + (size_t)512 * 1024);
        transpose_mat<0>(C, w_in, 1024, 5632, 0, 512, WFV);
        transpose_mat<0>(C, w_in, 1024, 5632, 1536, 1024, WFV + (size_t)512 * 1024);
        transpose_mat<0>(C, w_in, 1024, 5632, 2560, 1024, WGRET);
        transpose_mat<0>(C, w_in, 1024, 5632, 3584, 1024, WGA, nullptr, -1.4426950408889634f);
        transpose_mat<0>(C, w_in, 1024, 5632, 4608, 1024, WGB, nullptr, -1.4426950408889634f);
        transpose_mat<0>(C, w_ret, 1024, 1024, 0, 1024, WRET);
        transpose_mat<0>(C, w_out, 1024, 1024, 0, 1024, WOUT);
        transpose_mat<2>(C, w_up, 1024, 5632, 0, 5632, WUP, norm2_g);
        transpose_mat<0>(C, w_down, 2816, 1024, 0, 1024, WDOWN);
        fold_w4(C, w_four, W4);
        gen_tab(C, TAB, decay_logit, LG);
        for (int m = C.gw; m < NTOK; m += 2 * C.NGW) { const int m2 = (m + C.NGW < NTOK) ? m + C.NGW : m;
            rms_row2_to_bf16(C.lane, (m < NTOK_P ? x_p + (size_t)m * D : x_s + (size_t)(m - NTOK_P) * D), (m2 < NTOK_P ? x_p + (size_t)m2 * D : x_s + (size_t)(m2 - NTOK_P) * D), norm1_g, XN + (size_t)m * D, XN + (size_t)m2 * D); }
        gen_dm(C, DM);
        __syncthreads();
    }
    SEAM(0);
    if (IN(1)) {
        { pg8::Gemm g{1024, 1024, 1024}; SchedG S; S.so.init(NTOK / 256, 4, G, bx); S.A = (const char*)XN; S.B = (const char*)WQK; S.tsa = T1K; S.tsb = T1K; S.pm_off = 0;
          pg8::EpiRotary E{QK, TAB}; GEMM_CALL(pg8::EpiRotary, SchedG, g, S, E); }
        { pg8::Gemm g{1024, 1024, 1024}; SchedG S; S.so.init(6, NTOK / 256, G, bx); S.A = (const char*)WFV; S.B = (const char*)XN; S.tsa = T1K; S.tsb = T1K; S.pm_off = 0;
          pg8::EpiStoreFV E{FV, FV + (size_t)512 * NTOK}; GEMM_CALL(pg8::EpiStoreFV, SchedG, g, S, E); }
    }
    SEAM(1);
    if (IN(2)) { fold_ft(C, FV); r1_phase(C, QK, VT, LS, LG); }
    SEAM(2);
    if (IN(3)) {
        if (bx < G / 2) { Ctx C2 = C; C2.gtid = bx * 512 + C.tid; C2.NT = (G / 2) * 512; r2_phase(C2, LS, LG); }
#ifndef DBG_NO_DFT
        { pg8::Gemm g{8192, NTOK, SP / 2}; SchedDFT S; S.so.init(2 * 8, 4 * 2, G, (bx + G / 2) % G); S.DM = (const char*)DM; S.FT = (const char*)FV; S.ntile = 8; S.S = SP; S.tok0 = 0; S.lda_b = (size_t)8192 * 2;
          pg8::EpiDFT E{AB, FV, 1.41421356237f}; GEMM_CALL(pg8::EpiDFT, SchedDFT, g, S, E); }
        { pg8::Gemm g{4096, NTOK, SS / 2}; SchedDFT S; S.so.init(2 * 16, 8 * 2, G, bx); S.DM = (const char*)DM; S.FT = (const char*)FV; S.ntile = 16; S.S = SS; S.tok0 = NTOK_P; S.lda_b = (size_t)4096 * 2;
          pg8::EpiDFT E{AB, FV, 1.0f}; GEMM_CALL(pg8::EpiDFT, SchedDFT, g, S, E); }
#endif
        dft_nyquist(C, FV, AB);
    }
    SEAM(3);
    if (IN(4)) { r3_phase(C, QK, VT, LS, OB, LG); }
    SEAM(4);
    if (IN(5)) { pg8::Gemm g{1024, 1024, 1024}; SchedG S; S.so.init(NTOK / 256, 4, G, bx); S.A = (const char*)XN; S.B = (const char*)WGRET; S.tsa = T1K; S.tsb = T1K; S.pm_off = 0;
        pg8::EpiGateSilu E{OB}; GEMM_CALL(pg8::EpiGateSilu, SchedG, g, S, E); }
    SEAM(5);
    if (IN(6)) { pg8::Gemm g{1024, 1024, 1024}; SchedChain S; S.so.init(NTOK / 256, 4, G, bx); S.AB = (const char*)AB; S.ws = (const char*)ws;
        bf16* scr = (bf16*)(ws + WS_SCR) + (size_t)bx * (2 * 65536);
        pg8::EpiChain E{scr, scr + 65536, BA}; GEMM_CALL(pg8::EpiChain, SchedChain, g, S, E); }
    SEAM(6);
    PG8_LAS float* xlds = (PG8_LAS float*)(C.lds + 131072);
    if (IN(7)) {
        { pg8::Gemm g{1024, 1024, 1024}; SchedG S; S.so.init(NTOK_P / 256, 4, G, bx); S.A = (const char*)BA; S.B = (const char*)WOUT; S.tsa = T1K; S.tsb = T1K; S.pm_off = 0;
          pg8::EpiResBf<false> E{x_p, XN, PS1, 0, xlds}; GEMM_CALL(pg8::EpiResBf<false>, SchedG, g, S, E); }
        { pg8::Gemm g{1024, 1024, 1024}; SchedG S; S.so.init(NTOK_S / 256, 4, G, bx); S.A = (const char*)(BA + (size_t)NTOK_P * 1024); S.B = (const char*)WOUT; S.tsa = T1K; S.tsb = T1K; S.pm_off = 0;
          pg8::EpiResBf<false> E{x_s, XN, PS1, NTOK_P, xlds}; GEMM_CALL(pg8::EpiResBf<false>, SchedG, g, S, E); }
    }
    SEAM(7);
    const size_t TDN = (size_t)256 * FF * 2;
    if (IN(8)) { pg8::Gemm g{1024, 1024, 1024}; SchedUp S; S.so.init(323, 22, G, bx); S.XN2 = (const char*)XN; S.W = (const char*)WUP;
        pg8::EpiConvGLU E{ACT, conv_w, conv_b, PS1, xlds}; GEMM_CALL(pg8::EpiConvGLU, SchedUp, g, S, E); }
    SEAM(8);
    if (IN(9)) { pg8::Gemm g{FF, FF, FF}; SchedG S; S.so.init(NTOK / 256, 4, G, bx); S.A = (const char*)ACT; S.B = (const char*)WDOWN; S.tsa = TDN; S.tsb = TDN; S.pm_off = 0;
        pg8::EpiResBf<true> E{XN, X2B, PS2, 0, xlds}; GEMM_CALL(pg8::EpiResBf<true>, SchedG, g, S, E); }
    SEAM(9);
    if (IN(10)) { final_rows(C, X2B, PS2, final_g, out); }
#undef IN
#undef SEAM
}

extern "C" void kernel_launch(void* const* d_in, const int* in_sizes, int n_in, void* d_out, int out_size, void* d_ws, size_t ws_size, hipStream_t stream) {
    static int grid = 0;
    if (grid == 0) {
        if (n_in != 14 || out_size != NTOK * D || ws_size < WS_END) { fprintf(stderr, "kernel_launch: unexpected shapes (n_in %d out %d ws %zu)\n", n_in, out_size, ws_size); grid = -1; return; }
        int dev = 0, cus = 0, per_cu = 0;
        if (hipGetDevice(&dev) != hipSuccess || hipDeviceGetAttribute(&cus, hipDeviceAttributeMultiprocessorCount, dev) != hipSuccess) { grid = -1; return; }
        if (hipFuncSetAttribute((const void*)fwd_kernel, hipFuncAttributeMaxDynamicSharedMemorySize, LDS_BYTES) != hipSuccess) { fprintf(stderr, "kernel_launch: hipFuncSetAttribute failed\n"); grid = -1; return; }
        if (hipOccupancyMaxActiveBlocksPerMultiprocessor(&per_cu, (const void*)fwd_kernel, 512, LDS_BYTES) != hipSuccess || per_cu < 1) { fprintf(stderr, "kernel_launch: occupancy query says %d\n", per_cu); per_cu = 1; }
        (void)hipGetLastError();
        grid = cus * per_cu;
    }
    if (grid < 0) return;
    Args a{};
    for (int i = 0; i < 14; ++i) a.in[i] = (const float*)d_in[i];
    a.out = (float*)d_out; a.ws = (unsigned char*)d_ws;
#if MK_N_LAUNCHES == 1
    a.ph_lo = 0; a.ph_hi = NPHASE;
    if (hipMemsetAsync(d_ws, 0, 16384, stream) != hipSuccess) { fprintf(stderr, "kernel_launch: memset of the barrier words failed\n"); return; }
    void* kargs[] = {&a};
    hipError_t e = hipLaunchCooperativeKernel((const void*)fwd_kernel, dim3(grid), dim3(512), kargs, LDS_BYTES, stream);
    if (e != hipSuccess) fprintf(stderr, "cooperative launch failed: %s (grid %d)\n", hipGetErrorString(e), grid);
#else
#ifdef DBG_STOP
    for (int p = 0; p <= DBG_STOP; ++p) { a.ph_lo = p; a.ph_hi = p + 1; hipLaunchKernelGGL(fwd_kernel, dim3(grid), dim3(512), LDS_BYTES, stream, a); }
    if (DBG_X) { a.ph_lo = 100; a.ph_hi = 101; hipLaunchKernelGGL(fwd_kernel, dim3(grid), dim3(512), LDS_BYTES, stream, a); }
#else
    for (int p = 0; p < NPHASE; ++p) { a.ph_lo = p; a.ph_hi = p + 1; hipLaunchKernelGGL(fwd_kernel, dim3(grid), dim3(512), LDS_BYTES, stream, a); }
#endif
#endif
}
```

```cpp
#include <hip/hip_runtime.h>
#include <hip/hip_cooperative_groups.h>
#include <cstdio>
#include <cstdint>
#include <cmath>
namespace cg = cooperative_groups;

#ifndef MK_N_LAUNCHES
#define MK_N_LAUNCHES 1
#endif

namespace pg8 {
#define PG8_LAS __attribute__((address_space(3)))
typedef unsigned short bf16_t;
typedef short bf16x8 __attribute__((ext_vector_type(8)));
typedef float f32x4 __attribute__((ext_vector_type(4)));
typedef unsigned u32x4 __attribute__((ext_vector_type(4)));
typedef unsigned u32x2 __attribute__((ext_vector_type(2)));
constexpr int BM = 256, BK = 64, HALF = 128, HTB = HALF * BK * 2  , STAGE_BYTES = 8 * HTB, NXCD = 8, WGM = 8;

__host__ __device__ __forceinline__ int lds_byte(int r, int c) { const int st = (r >> 4) * 2 + (c >> 5), rr = r & 15, cc = c & 31, ob = rr * 64 + cc * 2; return st * 1024 + (ob ^ (((ob >> 9) & 1) << 5)); }
__host__ __device__ __forceinline__ void stage_rc(int b, int& R, int& C) { const int st = b / 1024, sb = b % 1024, swz = sb ^ (((sb >> 9) & 1) << 5); R = (st >> 1) * 16 + swz / 64; C = (st & 1) * 32 + (swz % 64) / 2; }
__host__ __device__ __forceinline__ int perm32(int rho) { const int n = rho >> 4, i = rho & 15; return 8 * (i >> 2) + 4 * n + (i & 3); }

struct Unit { int pm, pn; const char* pa; const char* pb; int r0, c0, aux, S; };
struct Gemm { int lda, ldb, K; };

struct StaticOrder {
    int nM, nN, nwg, G, c;
    __host__ __device__ void init(int nM_, int nN_, int G_, int c_) { nM = nM_; nN = nN_; nwg = nM * nN; G = G_; c = c_; }
    __host__ __device__ bool next(int i, Unit& u) const {
        const long L = (long)i * G + c; if (L >= nwg) return false;
        int wgid = (int)L; { const int q = nwg / NXCD, r = nwg % NXCD, xcd = wgid % NXCD, off = wgid / NXCD; wgid = (xcd < r ? xcd * (q + 1) : r * (q + 1) + (xcd - r) * q) + off; }
        const int nig = WGM * nN, gid = wgid / nig, fm = gid * WGM, gsz = (nM - fm) < WGM ? (nM - fm) : WGM;
        u.pm = fm + ((wgid % nig) % gsz); u.pn = (wgid % nig) / gsz; return true;
    }
};

typedef float f32x2_ __attribute__((ext_vector_type(2)));
typedef __bf16 bf16x2_ __attribute__((ext_vector_type(2)));
__device__ __forceinline__ unsigned cvt_pk_bf16(float lo, float hi) { const f32x2_ v = {lo, hi}; const bf16x2_ b = __builtin_convertvector(v, bf16x2_); return __builtin_bit_cast(unsigned, b); }
__device__ __forceinline__ float bflo(unsigned w) { return __uint_as_float(w << 16); }
__device__ __forceinline__ float bfhi(unsigned w) { return __uint_as_float(w & 0xffff0000u); }
__device__ __forceinline__ float sigmoidf_(float x) { return __builtin_amdgcn_rcpf(1.0f + __builtin_amdgcn_exp2f(-1.4426950408889634f * x)); }

#define EPI_LOOP_AM _Pragma("unroll") for (int ai = 0; ai < 2; ++ai) _Pragma("unroll") for (int m = 0; m < 4; ++m)
typedef f32x4 AccT[2][2][4][2];

struct EpiStore {
    static constexpr bool PERM = true, AFTER_DRAIN = false;
    bf16_t* O; int ldc;
    __device__ __forceinline__ void operator()(AccT& acc, const Unit& u, int wr, int wc, int fr, int fq) const {
        const int row0 = u.pm * BM + wr * 64 + fr, col0 = u.pn * BM + wc * 32 + 8 * fq;
        EPI_LOOP_AM { bf16_t* rowp = O + (size_t)(row0 + ai * HALF + m * 16) * ldc + col0;
#pragma unroll
            for (int bj = 0; bj < 2; ++bj) { const f32x4 v0 = acc[ai][bj][m][0], v1 = acc[ai][bj][m][1];
                u32x4 w; w.x = cvt_pk_bf16(v0[0], v0[1]); w.y = cvt_pk_bf16(v0[2], v0[3]); w.z = cvt_pk_bf16(v1[0], v1[1]); w.w = cvt_pk_bf16(v1[2], v1[3]);
                *(u32x4*)(rowp + bj * HALF) = w; } }
    }
};

struct EpiStoreFV {
    static constexpr bool PERM = true, AFTER_DRAIN = false;
    bf16_t* FT; bf16_t* VTt;
    __device__ __forceinline__ void operator()(AccT& acc, const Unit& u, int wr, int wc, int fr, int fq) const {
        const int row0 = u.pm * BM + wr * 64 + fr, col0 = u.pn * BM + wc * 32 + 8 * fq;
        bf16_t* base; size_t s_m, s_ai, s_bj;
        if (u.pm < 2) { base = FT + (size_t)row0 * 81920 + col0; s_m = (size_t)16 * 81920; s_ai = (size_t)128 * 81920; s_bj = 128; }
        else { const int r = row0 - 512; base = VTt + ((size_t)((col0 >> 7) * 8 + (r >> 7)) * 128 + (r & 127)) * 128 + (col0 & 127); s_m = 16 * 128; s_ai = (size_t)128 * 128; s_bj = (size_t)8 * 128 * 128; }
        EPI_LOOP_AM { bf16_t* rowp = base + ai * s_ai + m * s_m;
#pragma unroll
            for (int bj = 0; bj < 2; ++bj) { const f32x4 v0 = acc[ai][bj][m][0], v1 = acc[ai][bj][m][1];
                u32x4 w; w.x = cvt_pk_bf16(v0[0], v0[1]); w.y = cvt_pk_bf16(v0[2], v0[3]); w.z = cvt_pk_bf16(v1[0], v1[1]); w.w = cvt_pk_bf16(v1[2], v1[3]);
                *(u32x4*)(rowp + bj * s_bj) = w; } }
    }
};

struct EpiDFT {
    static constexpr bool PERM = true, AFTER_DRAIN = false;
    bf16_t* AB; const bf16_t* FT; float scale;
    __device__ __forceinline__ void operator()(AccT& acc, const Unit& u, int wr, int wc, int fr, int fq) const {
        const int n0 = u.pm * BM + wr * 64 + fr, col0 = u.c0 + wc * 32 + 8 * fq; const bool sinp = u.aux != 0;
        float fn[2][8];
#pragma unroll
        for (int bj = 0; bj < 2; ++bj)
#pragma unroll
            for (int k = 0; k < 8; ++k) fn[bj][k] = sinp ? 0.f : bflo((unsigned)FT[(size_t)((col0 & 511) + bj * HALF + k) * 81920 + u.r0 + (u.S >> 1)]) * (1.0f / 1024.0f);
        EPI_LOOP_AM { const int n = n0 + ai * HALF + m * 16; const float sg = (n & 1) ? -1.f : 1.f;
            const float s1 = sinp ? -sg * scale : scale, s2 = sinp ? -s1 : s1, sn = sg * scale;
            bf16_t* p1 = AB + (size_t)(u.r0 + n) * 1024 + col0; bf16_t* p2 = AB + (size_t)(u.r0 + u.S - n) * 1024 + col0;
#pragma unroll
            for (int bj = 0; bj < 2; ++bj) { const f32x4 v0 = acc[ai][bj][m][0], v1 = acc[ai][bj][m][1];
                float r[8] = {v0[0], v0[1], v0[2], v0[3], v1[0], v1[1], v1[2], v1[3]};
#pragma unroll
                for (int k = 0; k < 8; ++k) r[k] = r[k] * s1 + sn * fn[bj][k];
                u32x4 w; w.x = cvt_pk_bf16(r[0], r[1]); w.y = cvt_pk_bf16(r[2], r[3]); w.z = cvt_pk_bf16(r[4], r[5]); w.w = cvt_pk_bf16(r[6], r[7]);
                *(u32x4*)(p1 + bj * HALF) = w;
                if (n > 0) { const unsigned sm = sinp ? 0x80008000u : 0u; u32x4 x; x.x = w.x ^ sm; x.y = w.y ^ sm; x.z = w.z ^ sm; x.w = w.w ^ sm;
                    *(u32x4*)(p2 + bj * HALF) = x; } } }
    }
};

typedef float f32x2v __attribute__((ext_vector_type(2)));
struct EpiGateSilu {
    static constexpr bool PERM = true, AFTER_DRAIN = false;
    bf16_t* O;
    __device__ __forceinline__ void operator()(AccT& acc, const Unit& u, int wr, int wc, int fr, int fq) const {
        const int row0 = u.pm * BM + wr * 64 + fr, col0 = u.pn * BM + wc * 32 + 8 * fq;
        bf16_t* base = O + (size_t)row0 * 1024 + col0;
        u32x4 ov[2][4][2];
        EPI_LOOP_AM {
#pragma unroll
            for (int bj = 0; bj < 2; ++bj) ov[ai][m][bj] = *(const u32x4*)(base + (ai * HALF + m * 16) * 1024 + bj * HALF); }
        EPI_LOOP_AM {
#pragma unroll
            for (int bj = 0; bj < 2; ++bj) { const u32x4 o = ov[ai][m][bj]; const unsigned owd[4] = {o.x, o.y, o.z, o.w}; unsigned rw[4];
#pragma unroll
                for (int k = 0; k < 4; ++k) { const f32x4 gq = acc[ai][bj][m][k >> 1]; const f32x2v g = (k & 1) ? (f32x2v){gq[2], gq[3]} : (f32x2v){gq[0], gq[1]};
                    const f32x2v t = g * (-1.4426950408889634f); f32x2v e; e.x = __builtin_amdgcn_exp2f(t.x); e.y = __builtin_amdgcn_exp2f(t.y); const f32x2v d = e + 1.0f;
                    f32x2v s; s.x = __builtin_amdgcn_rcpf(d.x); s.y = __builtin_amdgcn_rcpf(d.y);
                    const f32x2v ovv = {bflo(owd[k]), bfhi(owd[k])}; const f32x2v r = (ovv * g) * s; rw[k] = cvt_pk_bf16(r.x, r.y); }
                u32x4 w; w.x = rw[0]; w.y = rw[1]; w.z = rw[2]; w.w = rw[3];
                *(u32x4*)(base + (ai * HALF + m * 16) * 1024 + bj * HALF) = w; } }
    }
};

template <int MODE> struct EpiGateSig {
    static constexpr bool PERM = true, AFTER_DRAIN = false;
    bf16_t* BA; const bf16_t* BB;
    __device__ __forceinline__ void operator()(AccT& acc, const Unit& u, int wr, int wc, int fr, int fq) const {
        const int row0 = u.pm * BM + wr * 64 + fr, col0 = u.pn * BM + wc * 32 + 8 * fq;
        const size_t off0 = (size_t)row0 * 1024 + col0;
#pragma unroll
        for (int ai = 0; ai < 2; ++ai) {
            u32x4 av[4][2], bv[4][2];
#pragma unroll
            for (int m = 0; m < 4; ++m)
#pragma unroll
                for (int bj = 0; bj < 2; ++bj) { av[m][bj] = *(const u32x4*)(BA + off0 + (ai * HALF + m * 16) * 1024 + bj * HALF); if (MODE == 1) bv[m][bj] = *(const u32x4*)(BB + off0 + (ai * HALF + m * 16) * 1024 + bj * HALF); }
#pragma unroll
            for (int m = 0; m < 4; ++m)
#pragma unroll
                for (int bj = 0; bj < 2; ++bj) { const f32x4 g0 = acc[ai][bj][m][0], g1 = acc[ai][bj][m][1]; const u32x4 a = av[m][bj];
                    float r[8]; const float gg[8] = {g0[0], g0[1], g0[2], g0[3], g1[0], g1[1], g1[2], g1[3]}; const float aa[8] = {bflo(a.x), bfhi(a.x), bflo(a.y), bfhi(a.y), bflo(a.z), bfhi(a.z), bflo(a.w), bfhi(a.w)};
                    if (MODE == 0) {
#pragma unroll
                        for (int k = 0; k < 8; ++k) r[k] = aa[k] * sigmoidf_(gg[k]);
                    } else { const u32x4 b = bv[m][bj]; const float bb[8] = {bflo(b.x), bfhi(b.x), bflo(b.y), bfhi(b.y), bflo(b.z), bfhi(b.z), bflo(b.w), bfhi(b.w)};
#pragma unroll
                        for (int k = 0; k < 8; ++k) r[k] = aa[k] + bb[k] * sigmoidf_(gg[k]);
                    }
                    u32x4 w; w.x = cvt_pk_bf16(r[0], r[1]); w.y = cvt_pk_bf16(r[2], r[3]); w.z = cvt_pk_bf16(r[4], r[5]); w.w = cvt_pk_bf16(r[6], r[7]);
                    *(u32x4*)(BA + off0 + (ai * HALF + m * 16) * 1024 + bj * HALF) = w; }
        }
    }
};

typedef float f32x2 __attribute__((ext_vector_type(2)));
struct EpiChain {
    static constexpr bool PERM = true, AFTER_DRAIN = false;
    bf16_t* SA; bf16_t* SB; bf16_t* BA;
    __device__ __forceinline__ void operator()(AccT& acc, const Unit& u, int wr, int wc, int fr, int fq) const {
        int frr = fr, fqq = fq; asm volatile("" : "+v"(frr), "+v"(fqq));
        const int st = u.aux; const int loff = (wr * 64 + frr) * 256 + wc * 32 + 8 * fqq;
        if (st == 0 || st == 2) { bf16_t* T = (st == 0) ? SA : SB;
            EPI_LOOP_AM {
#pragma unroll
                for (int bj = 0; bj < 2; ++bj) { const f32x4 v0 = acc[ai][bj][m][0], v1 = acc[ai][bj][m][1];
                    u32x4 w; w.x = cvt_pk_bf16(v0[0], v0[1]); w.y = cvt_pk_bf16(v0[2], v0[3]); w.z = cvt_pk_bf16(v1[0], v1[1]); w.w = cvt_pk_bf16(v1[2], v1[3]);
                    *(u32x4*)(T + loff + (ai * HALF + m * 16) * 256 + bj * HALF) = w; } }
        } else if (st == 1) {
            EPI_LOOP_AM {
#pragma unroll
                for (int bj = 0; bj < 2; ++bj) { const int lo = loff + (ai * HALF + m * 16) * 256 + bj * HALF; const u32x4 a = *(const u32x4*)(SA + lo);
                    const unsigned aw[4] = {a.x, a.y, a.z, a.w}; unsigned ow[4];
#pragma unroll
                    for (int k = 0; k < 4; ++k) { const f32x4 gq = acc[ai][bj][m][k >> 1]; const f32x2 g = (k & 1) ? (f32x2){gq[2], gq[3]} : (f32x2){gq[0], gq[1]};
                        f32x2 e; e.x = __builtin_amdgcn_exp2f(g.x); e.y = __builtin_amdgcn_exp2f(g.y);     const f32x2 d = e + 1.0f;
                        f32x2 s; s.x = __builtin_amdgcn_rcpf(d.x); s.y = __builtin_amdgcn_rcpf(d.y);
                        const f32x2 av = {bflo(aw[k]), bfhi(aw[k])}; const f32x2 r = av * s; ow[k] = cvt_pk_bf16(r.x, r.y); }
                    u32x4 w; w.x = ow[0]; w.y = ow[1]; w.z = ow[2]; w.w = ow[3]; *(u32x4*)(SA + lo) = w; } }
        } else {
            bf16_t* gout = BA + (size_t)(u.pm * BM + wr * 64 + frr) * 1024 + u.pn * BM + wc * 32 + 8 * fqq;
            EPI_LOOP_AM {
#pragma unroll
                for (int bj = 0; bj < 2; ++bj) { const int lo = loff + (ai * HALF + m * 16) * 256 + bj * HALF; const u32x4 a = *(const u32x4*)(SA + lo), b = *(const u32x4*)(SB + lo);
                    const unsigned aw[4] = {a.x, a.y, a.z, a.w}, bw[4] = {b.x, b.y, b.z, b.w}; unsigned ow[4];
#pragma unroll
                    for (int k = 0; k < 4; ++k) { const f32x4 gq = acc[ai][bj][m][k >> 1]; const f32x2 g = (k & 1) ? (f32x2){gq[2], gq[3]} : (f32x2){gq[0], gq[1]};
                        f32x2 e; e.x = __builtin_amdgcn_exp2f(g.x); e.y = __builtin_amdgcn_exp2f(g.y);     const f32x2 d = e + 1.0f;
                        f32x2 s; s.x = __builtin_amdgcn_rcpf(d.x); s.y = __builtin_amdgcn_rcpf(d.y);
                        const f32x2 av = {bflo(aw[k]), bfhi(aw[k])}, bv = {bflo(bw[k]), bfhi(bw[k])}; const f32x2 r = bv * s + av; ow[k] = cvt_pk_bf16(r.x, r.y); }
                    u32x4 w; w.x = ow[0]; w.y = ow[1]; w.z = ow[2]; w.w = ow[3]; *(u32x4*)(gout + (size_t)(ai * HALF + m * 16) * 1024 + bj * HALF) = w; } }
        }
    }
};


__device__ __forceinline__ f32x2 gelu_pk(f32x2 v) {
    const f32x2 av = __builtin_elementwise_abs(v), d = av * 0.2316418882f + 1.0f;
    f32x2 t; t.x = __builtin_amdgcn_rcpf(d.x); t.y = __builtin_amdgcn_rcpf(d.y);
    f32x2 q = t * 0.5307027145f + (-0.7265760135f); q = q * t + 0.7107068705f; q = q * t + (-0.142248368f); q = q * t + 0.127414796f; q = q * t;
    const f32x2 s = (v * v) * (-0.72134752044f);
    f32x2 e; e.x = __builtin_amdgcn_exp2f(s.x); e.y = __builtin_amdgcn_exp2f(s.y);
    const f32x2 m = v * (q * e), r = v - m;
    f32x2 o; o.x = v.x < 0.f ? m.x : r.x; o.y = v.y < 0.f ? m.y : r.y; return o;
}
__device__ __forceinline__ float dpp_ror1(float v)  { return __builtin_bit_cast(float, __builtin_amdgcn_update_dpp(0, __builtin_bit_cast(int, v), 0x121, 0xF, 0xF, false)); }
__device__ __forceinline__ float dpp_shr1_old(float old, float v) { return __builtin_bit_cast(float, __builtin_amdgcn_update_dpp(__builtin_bit_cast(int, old), __builtin_bit_cast(int, v), 0x111, 0xF, 0xF, false)); }
__device__ __forceinline__ float dpp_shl1_old(float old, float v) { return __builtin_bit_cast(float, __builtin_amdgcn_update_dpp(__builtin_bit_cast(int, old), __builtin_bit_cast(int, v), 0x101, 0xF, 0xF, false)); }
__device__ __forceinline__ float dpp_ror15(float v) { return __builtin_bit_cast(float, __builtin_amdgcn_update_dpp(0, __builtin_bit_cast(int, v), 0x12F, 0xF, 0xF, false)); }

struct EpiConvGLU {
    static constexpr bool PERM = true, AFTER_DRAIN = false;
    bf16_t* ACT; const float* cw; const float* cb; const float* PS; PG8_LAS float* xch;
    __device__ __forceinline__ void operator()(AccT& acc, const Unit& u, int wr, int wc, int fr, int fq) const {
        const int wid = wr * 4 + wc; PG8_LAS float* my = xch + wid * 128;
        EPI_LOOP_AM { const int gr = u.c0 + ai * HALF + wr * 64 + 4 * fr + m; const int grow = gr < 0 ? 0 : (gr >= 81920 ? 81919 : gr);
            const f32x4 p = *(const f32x4*)(PS + (size_t)grow * 4); const float rr = __builtin_amdgcn_rsqf(((p[0] + p[1]) + (p[2] + p[3])) * (1.0f / 1024.0f) + 1e-6f);
#pragma unroll
            for (int bj = 0; bj < 2; ++bj)
#pragma unroll
                for (int n = 0; n < 2; ++n) acc[ai][bj][m][n] = acc[ai][bj][m][n] * rr; }
        if (fr == 0) {
#pragma unroll
            for (int ai = 0; ai < 2; ++ai) { *(PG8_LAS f32x4*)(my + (ai * 2 + 0) * 32 + fq * 8) = acc[ai][0][0][0]; *(PG8_LAS f32x4*)(my + (ai * 2 + 0) * 32 + fq * 8 + 4) = acc[ai][0][0][1]; } }
        if (fr == 15) {
#pragma unroll
            for (int ai = 0; ai < 2; ++ai) { *(PG8_LAS f32x4*)(my + (ai * 2 + 1) * 32 + fq * 8) = acc[ai][0][3][0]; *(PG8_LAS f32x4*)(my + (ai * 2 + 1) * 32 + fq * 8 + 4) = acc[ai][0][3][1]; } }
        asm volatile("s_waitcnt lgkmcnt(0)" ::: "memory"); __builtin_amdgcn_s_barrier(); asm volatile("" ::: "memory");
        const int ch0 = u.pn * 128 + wc * 32 + fq * 8;
        const bool anyb = ((u.c0 + 256) >> 12) != (u.c0 >> 12);
        f32x4 cwv[2][4];
#pragma unroll
        for (int n = 0; n < 2; ++n) { cwv[n][0] = *(const f32x4*)(cw + ch0 + 4 * n); cwv[n][1] = *(const f32x4*)(cw + 2816 + ch0 + 4 * n); cwv[n][2] = *(const f32x4*)(cw + 5632 + ch0 + 4 * n); cwv[n][3] = *(const f32x4*)(cb + ch0 + 4 * n); }
#pragma unroll
        for (int ai = 0; ai < 2; ++ai) {
            const bool hasp = (wr == 1) || (ai == 1), hasn = (wr == 0) || (ai == 0);
            const PG8_LAS float* pp = xch + (wr == 1 ? (wid - 4) * 128 + (ai * 2 + 1) * 32 : (wid + 4) * 128 + (0 * 2 + 1) * 32) + fq * 8;
            const PG8_LAS float* pn_ = xch + (wr == 0 ? (wid + 4) * 128 + (ai * 2 + 0) * 32 : (wid - 4) * 128 + (1 * 2 + 0) * 32) + fq * 8;
            f32x4 upE[2], dnE[2];
#pragma unroll
            for (int n = 0; n < 2; ++n) { f32x4 pv = (f32x4){0.f, 0.f, 0.f, 0.f}, nv = (f32x4){0.f, 0.f, 0.f, 0.f}; if (hasp) pv = *(const PG8_LAS f32x4*)(pp + 4 * n); if (hasn) nv = *(const PG8_LAS f32x4*)(pn_ + 4 * n);
#pragma unroll
                for (int j = 0; j < 4; ++j) { upE[n][j] = dpp_shr1_old(pv[j], acc[ai][0][3][n][j]); dnE[n][j] = dpp_shl1_old(nv[j], acc[ai][0][0][n][j]); } }
#pragma unroll
            for (int m = 0; m < 4; ++m) {
                const int r = ai * HALF + wr * 64 + 4 * fr + m, gr = u.c0 + r; const int S = gr < 16384 ? 4096 : 8192, pos = gr & (S - 1);
                u32x4 w4;
#pragma unroll
                for (int n = 0; n < 2; ++n) {
                    f32x4 up = (m == 0) ? upE[n] : acc[ai][0][m > 0 ? m - 1 : 0][n], dn = (m == 3) ? dnE[n] : acc[ai][0][m < 3 ? m + 1 : 3][n];
                    if (anyb) { if (pos == 0) up = (f32x4){0.f, 0.f, 0.f, 0.f}; if (pos == S - 1) dn = (f32x4){0.f, 0.f, 0.f, 0.f}; }
                    const f32x4 x = cwv[n][0] * up + cwv[n][1] * acc[ai][0][m][n] + cwv[n][2] * dn + cwv[n][3], vv = acc[ai][1][m][n];
                    const f32x2 ga = gelu_pk((f32x2){x[0], x[1]}), gb = gelu_pk((f32x2){x[2], x[3]});
                    const unsigned lo = cvt_pk_bf16(ga.x * vv[0], ga.y * vv[1]), hi = cvt_pk_bf16(gb.x * vv[2], gb.y * vv[3]);
                    if (n == 0) { w4.x = lo; w4.y = hi; } else { w4.z = lo; w4.w = hi; }
                }
                if (r >= 1 && r <= 254 && gr < 81920) __builtin_nontemporal_store(w4, (u32x4*)(ACT + (size_t)gr * 2816 + ch0));
            }
        }
    }
};

template <bool BASE_BF16> struct EpiResBf {
    static constexpr bool PERM = true, AFTER_DRAIN = false;
    const void* base; bf16_t* Y; float* PS; int grow0; PG8_LAS float* xs;
    __device__ __forceinline__ void operator()(AccT& acc, const Unit& u, int wr, int wc, int fr, int fq) const {
        const int row0 = u.pm * BM + wr * 64 + fr, col0 = u.pn * BM + wc * 32 + 8 * fq;
        const size_t off0 = (size_t)row0 * 1024 + col0;
#pragma unroll
        for (int ai = 0; ai < 2; ++ai) {
            f32x4 bs[4][2][2];
#pragma unroll
            for (int m = 0; m < 4; ++m)
#pragma unroll
                for (int bj = 0; bj < 2; ++bj) { const size_t off = off0 + (size_t)(ai * HALF + m * 16) * 1024 + bj * HALF;
                    if (BASE_BF16) { const u32x4 w = *(const u32x4*)((const bf16_t*)base + off); bs[m][bj][0] = (f32x4){bflo(w.x), bfhi(w.x), bflo(w.y), bfhi(w.y)}; bs[m][bj][1] = (f32x4){bflo(w.z), bfhi(w.z), bflo(w.w), bfhi(w.w)}; }
                    else { bs[m][bj][0] = *(const f32x4*)((const float*)base + off); bs[m][bj][1] = *(const f32x4*)((const float*)base + off + 4); } }
#pragma unroll
            for (int m = 0; m < 4; ++m) { const size_t offy = off0 + (size_t)(ai * HALF + m * 16) * 1024 + (size_t)grow0 * 1024; f32x4 sv = (f32x4){0.f, 0.f, 0.f, 0.f};
#pragma unroll
                for (int bj = 0; bj < 2; ++bj) { const f32x4 y0 = bs[m][bj][0] + acc[ai][bj][m][0], y1 = bs[m][bj][1] + acc[ai][bj][m][1];
                    sv = sv + y0 * y0; sv = sv + y1 * y1;
                    u32x4 o; o.x = cvt_pk_bf16(y0[0], y0[1]); o.y = cvt_pk_bf16(y0[2], y0[3]); o.z = cvt_pk_bf16(y1[0], y1[1]); o.w = cvt_pk_bf16(y1[2], y1[3]); *(u32x4*)(Y + offy + bj * HALF) = o; }
                float s = (sv[0] + sv[1]) + (sv[2] + sv[3]);
                { const auto r16 = __builtin_amdgcn_permlane16_swap(__float_as_uint(s), __float_as_uint(s), false, false); s = __uint_as_float(r16[0]) + __uint_as_float(r16[1]); }
                { const auto r32 = __builtin_amdgcn_permlane32_swap(__float_as_uint(s), __float_as_uint(s), false, false); s = __uint_as_float(r32[0]) + __uint_as_float(r32[1]); }
                if (fq == 0) xs[(ai * HALF + wr * 64 + m * 16 + fr) * 4 + wc] = s; }
        }
        asm volatile("s_waitcnt lgkmcnt(0)" ::: "memory"); __builtin_amdgcn_s_barrier(); asm volatile("" ::: "memory");
        const int tid = (wr * 4 + wc) * 64 + fq * 16 + fr;
        if (tid < 256) { const f32x4 p = *(const PG8_LAS f32x4*)(xs + tid * 4); PS[(size_t)(grow0 + u.pm * BM + tid) * 4 + u.pn] = (p[0] + p[1]) + (p[2] + p[3]); }
    }
};

struct EpiRotary {
    static constexpr bool PERM = true, AFTER_DRAIN = false;
    bf16_t* QK; const float* tab;
    __device__ __forceinline__ void operator()(AccT& acc, const Unit& u, int wr, int wc, int fr, int fq) const {
        const int row0 = u.pm * BM + wr * 64 + fr; const int S = (u.pm < 64) ? 4096 : 8192; const float sc = (u.pn < 2) ? 0.125f : 1.0f;
        const int part = u.pn >> 1, hb = (u.pn & 1) * 4 + (wc >> 1), d0 = 32 * (wc & 1) + 8 * fq, p0 = 16 * (wc & 1) + 4 * fq;
        bf16_t* qbase = QK + ((((size_t)part * 640 + 2 * u.pm) * 8 + hb) * 128 + wr * 64 + fr) * 64 + d0;
        f32x4 tb[2][4][2];
        EPI_LOOP_AM { const int t = row0 + ai * HALF + m * 16, pos = t & (S - 1); const float* tp = tab + ((size_t)pos * 32 + p0) * 2; tb[ai][m][0] = *(const f32x4*)tp; tb[ai][m][1] = *(const f32x4*)(tp + 4); }
        EPI_LOOP_AM { const f32x4 t0 = tb[ai][m][0], t1 = tb[ai][m][1];
            const f32x4 cs = {t0[0], t0[2], t1[0], t1[2]}, sn = {t0[1], t0[3], t1[1], t1[3]};
#pragma unroll
            for (int bj = 0; bj < 2; ++bj) { const f32x4 x1 = acc[ai][bj][m][0], x2 = acc[ai][bj][m][1];
                const f32x4 y1 = x1 * cs - x2 * sn, y2 = x1 * sn + x2 * cs;
                u32x4 w; w.x = cvt_pk_bf16(y1[0], y1[1]); w.y = cvt_pk_bf16(y1[2], y1[3]); w.z = cvt_pk_bf16(y2[0], y2[1]); w.w = cvt_pk_bf16(y2[2], y2[3]);
                *(u32x4*)(qbase + ai * (8 * 128 * 64) + m * (16 * 64) + bj * (2 * 128 * 64)) = w; } }
    }
};

template <class E> struct ARowPerm { static constexpr bool value = false; };
template <> struct ARowPerm<EpiConvGLU> { static constexpr bool value = true; };
template <class Epi, class Sched, bool ALIGN_EPI = false, bool SP2 = false>
__device__ __forceinline__ void gemm_phase(PG8_LAS unsigned char* lds, const Gemm g, const Sched& S, const Epi& E) {
    const int tid = threadIdx.x, wid = __builtin_amdgcn_readfirstlane(tid >> 6), lane = tid & 63, wr = wid >> 2, wc = wid & 3, fr = lane & 15, fq = lane >> 4;
    const int K = g.K, nt = K / BK;
    unsigned voffA[2], voffB[2];
#pragma unroll
    for (int i = 0; i < 2; ++i) { int R, C; stage_rc(tid * 16 + i * 8192, R, C); const int Rb = Epi::PERM ? ((R & ~31) + perm32(R & 31)) : R;
        const int Ra = ARowPerm<Epi>::value ? ((R & ~63) + 4 * (R & 15) + ((R >> 4) & 3)) : R;
        voffA[i] = (unsigned)(Ra * g.lda + C) * 2u; voffB[i] = (unsigned)(Rb * g.ldb + C) * 2u; }
    const size_t kstep = (size_t)(BK * 2);
    const size_t hsA = (size_t)HALF * g.lda * 2, hsB = (size_t)HALF * g.ldb * 2;
    const unsigned ldsw = (unsigned)wid * 1024u;
    const int aoff = lds_byte(wr * 64 + fr, fq * 8), boff = lds_byte(wc * 32 + fr, fq * 8);
#define PG8_SA(b, h) (((b) * 2 + (h)) * HTB)
#define PG8_SB(b, h) ((4 + (b) * 2 + (h)) * HTB)
#define PG8_STAGE(bufoff, gbase, voff) do { _Pragma("unroll") for (int _i = 0; _i < 2; ++_i) \
        __builtin_amdgcn_global_load_lds((const unsigned*)((const char*)(gbase) + (voff)[_i]), (PG8_LAS unsigned*)(lds + (bufoff) + ldsw + _i * 8192), 16, 0, 0); } while (0)
#define PG8_LDA(dst, b, h) do { _Pragma("unroll") for (int m = 0; m < 4; ++m) _Pragma("unroll") for (int k = 0; k < 2; ++k) dst[m][k] = *(const PG8_LAS bf16x8*)(lds + PG8_SA(b, h) + aoff + m * 2048 + k * 1024); } while (0)
#define PG8_LDB(dst, b, h) do { _Pragma("unroll") for (int n = 0; n < 2; ++n) _Pragma("unroll") for (int k = 0; k < 2; ++k) dst[n][k] = *(const PG8_LAS bf16x8*)(lds + PG8_SB(b, h) + boff + n * 2048 + k * 1024); } while (0)
#define PG8_MMA(ai, bj, At, Bt) do { __builtin_amdgcn_s_setprio(1); _Pragma("unroll") for (int m = 0; m < 4; ++m) _Pragma("unroll") for (int n = 0; n < 2; ++n) _Pragma("unroll") for (int k = 0; k < 2; ++k) \
        acc[ai][bj][m][n] = __builtin_amdgcn_mfma_f32_16x16x32_bf16(Bt[n][k], At[m][k], acc[ai][bj][m][n], 0, 0, 0); __builtin_amdgcn_s_setprio(0); } while (0)
#define PG8_WAIT_V(n) asm volatile("s_waitcnt vmcnt(" #n ")" ::: "memory")
#define PG8_WAIT_L(n) asm volatile("s_waitcnt lgkmcnt(" #n ")" ::: "memory")
#define PG8_BAR __builtin_amdgcn_s_barrier()
#define PG8_SCHED __builtin_amdgcn_sched_barrier(0)
    Unit cur, nxt; int ui = 0;
    if (!S.next(0, cur)) return;
    f32x4 acc[2][2][4][2];
#pragma unroll
    for (int a = 0; a < 2; ++a)
#pragma unroll
        for (int b = 0; b < 2; ++b)
#pragma unroll
            for (int m = 0; m < 4; ++m)
#pragma unroll
                for (int n = 0; n < 2; ++n) acc[a][b][m][n] = (f32x4){0.f, 0.f, 0.f, 0.f};
    bf16x8 At[4][2], B0[2][2], B1[2][2];
    const char* cA = cur.pa; const char* cB = cur.pb;

    if constexpr (SP2) {
        PG8_STAGE(PG8_SB(0, 0), cB, voffB); PG8_STAGE(PG8_SB(0, 1), cB + hsB, voffB); PG8_STAGE(PG8_SA(0, 0), cA, voffA); PG8_STAGE(PG8_SA(0, 1), cA + hsA, voffA);
        if (wr == 1) PG8_BAR;
        PG8_WAIT_V(2); PG8_BAR;
        PG8_STAGE(PG8_SB(1, 0), cB + kstep, voffB); PG8_STAGE(PG8_SA(1, 0), cA + kstep, voffA); PG8_STAGE(PG8_SB(1, 1), cB + hsB + kstep, voffB);
        PG8_WAIT_V(6); PG8_BAR;
    } else {
        PG8_STAGE(PG8_SB(0, 0), cB, voffB); PG8_STAGE(PG8_SA(0, 0), cA, voffA); PG8_STAGE(PG8_SB(0, 1), cB + hsB, voffB); PG8_STAGE(PG8_SA(0, 1), cA + hsA, voffA);
        if (wr == 1) PG8_BAR;
        PG8_WAIT_V(4); PG8_BAR;
        PG8_STAGE(PG8_SB(1, 0), cB + kstep, voffB); PG8_STAGE(PG8_SA(1, 0), cA + kstep, voffA); PG8_STAGE(PG8_SB(1, 1), cB + hsB + kstep, voffB);
        PG8_WAIT_V(6); PG8_BAR;
    }
    for (;;) {
        const bool has_next = S.next(ui + 1, nxt);
        const char* nA = has_next ? nxt.pa : cA; const char* nB = has_next ? nxt.pb : cB;
        for (int t = 0; t < nt; t += 2) {
            const bool last = (t == nt - 2);
            const char* a1 = cA + (size_t)(t + 1) * kstep;
            const char* a2 = last ? nA : cA + (size_t)(t + 2) * kstep; const char* b2 = last ? nB : cB + (size_t)(t + 2) * kstep;
            const char* a3 = a2 + kstep; const char* b3 = b2 + kstep;

            if constexpr (SP2) {
            PG8_LDB(B0, 0, 0); PG8_LDB(B1, 0, 1); PG8_SCHED; PG8_LDA(At, 0, 0); PG8_STAGE(PG8_SA(1, 1), a1 + hsA, voffA);
            PG8_WAIT_V(8); PG8_WAIT_L(0); PG8_BAR; PG8_MMA(0, 0, At, B0); PG8_MMA(0, 1, At, B1); PG8_BAR; PG8_SCHED;
            PG8_LDA(At, 0, 1); PG8_STAGE(PG8_SB(0, 0), b2, voffB); PG8_STAGE(PG8_SB(0, 1), b2 + hsB, voffB); PG8_STAGE(PG8_SA(0, 0), a2, voffA);
            PG8_WAIT_V(8); PG8_WAIT_L(0); PG8_BAR; PG8_MMA(1, 0, At, B0); PG8_MMA(1, 1, At, B1); PG8_BAR; PG8_SCHED;
            PG8_LDB(B0, 1, 0); PG8_LDB(B1, 1, 1); PG8_SCHED; PG8_LDA(At, 1, 0); PG8_STAGE(PG8_SA(0, 1), a2 + hsA, voffA);
            PG8_WAIT_V(8); PG8_WAIT_L(0); PG8_BAR; PG8_MMA(0, 0, At, B0); PG8_MMA(0, 1, At, B1); PG8_BAR; PG8_SCHED;
            PG8_LDA(At, 1, 1); PG8_STAGE(PG8_SB(1, 0), b3, voffB); PG8_STAGE(PG8_SB(1, 1), b3 + hsB, voffB); PG8_STAGE(PG8_SA(1, 0), a3, voffA);
            PG8_WAIT_V(8); PG8_WAIT_L(0); PG8_BAR; PG8_MMA(1, 0, At, B0); PG8_MMA(1, 1, At, B1); PG8_BAR; PG8_SCHED;
            } else {
            PG8_LDB(B0, 0, 0); PG8_SCHED; PG8_LDA(At, 0, 0); PG8_STAGE(PG8_SA(1, 1), a1 + hsA, voffA);
            PG8_WAIT_L(8); PG8_BAR; PG8_WAIT_L(0); PG8_MMA(0, 0, At, B0); PG8_BAR; PG8_SCHED;
            PG8_LDB(B1, 0, 1); PG8_STAGE(PG8_SB(0, 0), b2, voffB);
            PG8_BAR; PG8_WAIT_L(0); PG8_MMA(0, 1, At, B1); PG8_BAR;
            PG8_LDA(At, 0, 1); PG8_STAGE(PG8_SA(0, 0), a2, voffA);
            PG8_BAR; PG8_WAIT_L(0); PG8_MMA(1, 0, At, B0); PG8_BAR; PG8_SCHED;
            PG8_STAGE(PG8_SB(0, 1), b2 + hsB, voffB);
            PG8_WAIT_V(6); PG8_BAR; PG8_MMA(1, 1, At, B1); PG8_BAR;
            PG8_LDB(B0, 1, 0); PG8_SCHED; PG8_LDA(At, 1, 0); PG8_STAGE(PG8_SA(0, 1), a2 + hsA, voffA);
            PG8_WAIT_L(8); PG8_BAR; PG8_WAIT_L(0); PG8_MMA(0, 0, At, B0); PG8_BAR; PG8_SCHED;
            PG8_LDB(B1, 1, 1); PG8_STAGE(PG8_SB(1, 0), b3, voffB);
            PG8_BAR; PG8_WAIT_L(0); PG8_MMA(0, 1, At, B1); PG8_BAR;
            PG8_LDA(At, 1, 1); PG8_STAGE(PG8_SA(1, 0), a3, voffA);
            PG8_BAR; PG8_WAIT_L(0); PG8_MMA(1, 0, At, B0); PG8_BAR; PG8_SCHED;
            PG8_STAGE(PG8_SB(1, 1), b3 + hsB, voffB);
            PG8_WAIT_V(6); PG8_BAR; PG8_MMA(1, 1, At, B1); PG8_BAR;
            }
        }
        if constexpr (ALIGN_EPI) { if (wr == 0) PG8_BAR; }
        if constexpr (!Epi::AFTER_DRAIN) { E(acc, cur, wr, wc, fr, fq); }
        if (!has_next) break;
#pragma unroll
        for (int a = 0; a < 2; ++a)
#pragma unroll
            for (int b = 0; b < 2; ++b)
#pragma unroll
                for (int m = 0; m < 4; ++m)
#pragma unroll
                    for (int n = 0; n < 2; ++n) acc[a][b][m][n] = (f32x4){0.f, 0.f, 0.f, 0.f};
        cur = nxt; cA = nA; cB = nB; ++ui;
        if constexpr (ALIGN_EPI) { if (wr == 1) PG8_BAR; }
    }
    PG8_WAIT_V(0);
    if constexpr (!ALIGN_EPI) { if (wr == 0) PG8_BAR; }
    PG8_BAR;
    if constexpr (Epi::AFTER_DRAIN) { E.fused(acc, cur, wr, wc, fr, fq, lds, wid, lane); }
#undef PG8_SA
#undef PG8_SB
#undef PG8_STAGE
#undef PG8_LDA
#undef PG8_LDB
#undef PG8_MMA
#undef PG8_WAIT_V
#undef PG8_WAIT_L
#undef PG8_BAR
#undef PG8_SCHED
}
}

constexpr int D = 1024, NTOK_P = 4 * 4096, NTOK_S = 8 * 8192, NTOK = NTOK_P + NTOK_S;
constexpr int SP = 4096, SS = 8192, FF = 2816, NCHUNK = NTOK / 128, NRU = NCHUNK * 8;
constexpr int HALF_TOK = NTOK / 2;
constexpr float NORM_EPS = 1e-6f, GN_EPS = 1e-5f;
constexpr size_t MiB = 1u << 20;
constexpr size_t WS_WQK = 1 * MiB, WS_WFV = 3 * MiB, WS_WGRET = 6 * MiB, WS_WGA = 8 * MiB, WS_WGB = 10 * MiB, WS_W4 = 12 * MiB, WS_WRET = 14 * MiB, WS_WOUT = 16 * MiB,
                 WS_WUP = 18 * MiB, WS_WDOWN = 29 * MiB, WS_TAB = 36 * MiB, WS_LG = 38 * MiB, WS_PS1 = 40 * MiB, WS_PS2 = 42 * MiB;
constexpr size_t WS_XN = 48 * MiB, WS_FV = 208 * MiB, WS_QK = 448 * MiB, WS_O = 608 * MiB, WS_DM = 768 * MiB, WS_SCR = 896 * MiB, WS_END = 960 * MiB;
constexpr size_t WS_BA = WS_FV, WS_BB = WS_QK;
constexpr size_t WS_ACT = 208 * MiB, WS_X2B = 648 * MiB;
constexpr size_t DO_AB = 0, DO_LS = 160 * MiB;
constexpr int LDS_BYTES = 147456;

#define LAS __attribute__((address_space(3)))
typedef unsigned short bf16;
typedef unsigned v4u __attribute__((ext_vector_type(4)));
typedef unsigned v2u __attribute__((ext_vector_type(2)));
typedef float f32x4 __attribute__((ext_vector_type(4)));
typedef short bf16x8 __attribute__((ext_vector_type(8)));
using pg8::cvt_pk_bf16; using pg8::bflo; using pg8::bfhi;
__device__ __forceinline__ float wave_sum(float v) {
#pragma unroll
    for (int o = 1; o < 64; o <<= 1) v += __shfl_xor(v, o);
    return v;
}
__device__ __forceinline__ float exp2_(float x) { return __builtin_amdgcn_exp2f(x); }

#define XB_TMO      128
#define XB_XCNT(j)  (256  + 64 * (j))
#define XB_XSUB(j)  (1280 + 64 * (j))
#define XB_XGEN(j)  (2304 + 64 * (j))
#define XB_TOP      3328
#define XB_TOPGEN   3392
#define XCD_BAR_WORDS 3456
#define XB_SPIN_CAP (1u << 18)

__device__ __forceinline__ unsigned xb_ld(unsigned* p)              { return __hip_atomic_load(p, __ATOMIC_RELAXED, __HIP_MEMORY_SCOPE_AGENT); }
__device__ __forceinline__ unsigned xb_add(unsigned* p, unsigned v) { return __hip_atomic_fetch_add(p, v, __ATOMIC_RELAXED, __HIP_MEMORY_SCOPE_AGENT); }
__device__ __forceinline__ unsigned xb_xcc_id() { return (unsigned)__builtin_amdgcn_s_getreg((3 << 11) | 20) & 0xFu; }
#define XB_SPIN(cond, bar) do { unsigned _sp = 0; while (cond) { __builtin_amdgcn_s_sleep(1); \
    if ((++_sp & 255u) == 0u) { if (xb_ld(&(bar)[XB_TMO])) break; if (_sp > XB_SPIN_CAP) { atomicAdd(&(bar)[XB_TMO], 1u); break; } } } } while (0)

struct XcdBarrier {
    unsigned* bar; unsigned x;
    volatile LAS unsigned* st;
};

__device__ __forceinline__ XcdBarrier xcd_barrier_post(unsigned* bar, volatile LAS unsigned* st) {
    XcdBarrier b; b.bar = bar; b.x = xb_xcc_id(); b.st = st;
    if (threadIdx.x == 0) (void)xb_add(&bar[XB_XCNT(b.x)], 1u);
    return b;
}
__device__ __forceinline__ void xcd_barrier_complete(unsigned* bar, unsigned x, unsigned& nloc, unsigned& nx) {
    const unsigned G = gridDim.x * gridDim.y * gridDim.z;
    unsigned sum, cnt, mine, sp = 0u;
    for (;;) {
        sum = 0u; cnt = 0u; mine = 0u;
#pragma unroll
        for (unsigned j = 0; j < 16; ++j) { const unsigned c = xb_ld(&bar[XB_XCNT(j)]); sum += c; cnt += (c > 0u) ? 1u : 0u; mine = (j == x) ? c : mine; }
        if (sum == G) break;
        __builtin_amdgcn_s_sleep(1);
        if ((++sp & 255u) == 0u) { if (xb_ld(&bar[XB_TMO])) break; if (sp > XB_SPIN_CAP) { atomicAdd(&bar[XB_TMO], 1u); break; } }
    }
    nloc = mine > 0u ? mine : 1u; nx = cnt > 0u ? cnt : 1u;
}

__device__ __forceinline__ void xcd_barrier(const XcdBarrier& b) {
    asm volatile("s_waitcnt vmcnt(0)" ::: "memory");
    __syncthreads();
    if (threadIdx.x == 0) {
        unsigned* bar = b.bar;
        __builtin_amdgcn_s_waitcnt(0);
        unsigned nloc = b.st[0], nx = b.st[1];
        if (nloc == 0u) { xcd_barrier_complete(bar, b.x, nloc, nx); b.st[0] = nloc; b.st[1] = nx; }
        const unsigned old = xb_add(&bar[XB_XSUB(b.x)], 1u);
        const unsigned gen = old / nloc;
        if (old + 1u == (gen + 1u) * nloc) {
            __builtin_amdgcn_fence(__ATOMIC_RELEASE, "agent");
            asm volatile("s_waitcnt vmcnt(0)" ::: "memory");
            const unsigned og = xb_add(&bar[XB_TOP], 1u);
            const unsigned tg = og / nx;
            if (og + 1u == (tg + 1u) * nx) xb_add(&bar[XB_TOPGEN], 1u);
            else XB_SPIN(xb_ld(&bar[XB_TOPGEN]) == tg, bar);
            __builtin_amdgcn_fence(__ATOMIC_ACQUIRE, "agent");
            xb_add(&bar[XB_XGEN(b.x)], 1u);
            asm volatile("s_waitcnt vmcnt(0)" ::: "memory");
        } else {
            XB_SPIN(xb_ld(&bar[XB_XGEN(b.x)]) == gen, bar);
            __builtin_amdgcn_fence(__ATOMIC_ACQUIRE, "agent");
            asm volatile("s_waitcnt vmcnt(0)" ::: "memory");
        }
    }
    __syncthreads();
}

#define LBAR() do { asm volatile("s_waitcnt lgkmcnt(0)" ::: "memory"); __builtin_amdgcn_s_barrier(); asm volatile("" ::: "memory"); } while (0)
struct Ctx { LAS unsigned char* lds; int tid, lane, wave, gw, NGW, gtid, NT; };

template <int MODE> __device__ __forceinline__ int rowmap(int n) {
    if (MODE == 1) { const int d = n & 63, p = d & 31; return (n & ~63) | ((p >> 2) << 3) | ((d >> 5) << 2) | (p & 3); }
    if (MODE == 2) { return n < FF ? 256 * (n / 128) + (n % 128) : 256 * ((n - FF) / 128) + 128 + ((n - FF) % 128); }
    return n;
}
template <int MODE> __device__ __forceinline__ void transpose_mat(const Ctx& C, const float* W, int Ksrc, int ldw, int col0, int ncols, bf16* WT, const float* kscale = nullptr, float sscale = 1.0f) {
    LAS float* scr = (LAS float*)(C.lds + C.wave * 16384);
    const int nblk = ncols / 32, nitems = (Ksrc / 64) * nblk, lane = C.lane;
    for (int it = C.gw; it < nitems; it += C.NGW) {
        const int kb = it / nblk, nb = it % nblk, k0 = 64 * kb, n0 = 32 * nb;
#pragma unroll 8
        for (int i = 0; i < 32; ++i) { const int kk = 2 * i + (lane >> 5); scr[kk * 33 + (lane & 31)] = W[(size_t)(k0 + kk) * ldw + col0 + n0 + (lane & 31)] * (kscale ? kscale[k0 + kk] * sscale : sscale); }
        asm volatile("s_waitcnt lgkmcnt(0)" ::: "memory");
        const int c = lane & 7;
#pragma unroll
        for (int j = 0; j < 4; ++j) { const int n = (lane >> 3) + 8 * j; const LAS float* s = scr + (8 * c) * 33 + n;
            v4u o; o.x = cvt_pk_bf16(s[0 * 33], s[1 * 33]); o.y = cvt_pk_bf16(s[2 * 33], s[3 * 33]); o.z = cvt_pk_bf16(s[4 * 33], s[5 * 33]); o.w = cvt_pk_bf16(s[6 * 33], s[7 * 33]);
            *(v4u*)(WT + (size_t)rowmap<MODE>(n0 + n) * Ksrc + k0 + 8 * c) = o; }
        asm volatile("s_waitcnt lgkmcnt(0)" ::: "memory");
    }
}
__device__ __forceinline__ void rms_row_to_bf16(int lane, const float* xrow, const float* g, bf16* orow) {
    const f32x4* xr = (const f32x4*)xrow + lane; const f32x4* gr = (const f32x4*)g + lane;
    f32x4 v[4]; float s = 0.f;
#pragma unroll
    for (int j = 0; j < 4; ++j) { v[j] = xr[64 * j]; s += (v[j].x * v[j].x + v[j].y * v[j].y) + (v[j].z * v[j].z + v[j].w * v[j].w); }
    const float r = 1.0f / sqrtf(wave_sum(s) * (1.f / D) + NORM_EPS);
    v2u* o8 = (v2u*)orow + lane;
#pragma unroll
    for (int j = 0; j < 4; ++j) { const f32x4 gg = gr[64 * j]; v2u w; w.x = cvt_pk_bf16(v[j].x * r * gg.x, v[j].y * r * gg.y); w.y = cvt_pk_bf16(v[j].z * r * gg.z, v[j].w * r * gg.w); o8[64 * j] = w; }
}
__device__ __forceinline__ void rms_row2_to_bf16(int lane, const float* xa, const float* xb, const float* g, bf16* oa, bf16* ob) {
    const f32x4* pa = (const f32x4*)xa + lane; const f32x4* pb = (const f32x4*)xb + lane; const f32x4* gr = (const f32x4*)g + lane;
    f32x4 va[4], vb[4]; float sa = 0.f, sb = 0.f;
#pragma unroll
    for (int j = 0; j < 4; ++j) { va[j] = pa[64 * j]; vb[j] = pb[64 * j]; }
#pragma unroll
    for (int j = 0; j < 4; ++j) { sa += (va[j].x * va[j].x + va[j].y * va[j].y) + (va[j].z * va[j].z + va[j].w * va[j].w); sb += (vb[j].x * vb[j].x + vb[j].y * vb[j].y) + (vb[j].z * vb[j].z + vb[j].w * vb[j].w); }
    const float ra = 1.0f / sqrtf(wave_sum(sa) * (1.f / D) + NORM_EPS), rb = 1.0f / sqrtf(wave_sum(sb) * (1.f / D) + NORM_EPS);
    v2u* o8a = (v2u*)oa + lane; v2u* o8b = (v2u*)ob + lane;
#pragma unroll
    for (int j = 0; j < 4; ++j) { const f32x4 gg = gr[64 * j]; v2u w; w.x = cvt_pk_bf16(va[j].x * ra * gg.x, va[j].y * ra * gg.y); w.y = cvt_pk_bf16(va[j].z * ra * gg.z, va[j].w * ra * gg.w); o8a[64 * j] = w;
        v2u z; z.x = cvt_pk_bf16(vb[j].x * rb * gg.x, vb[j].y * rb * gg.y); z.y = cvt_pk_bf16(vb[j].z * rb * gg.z, vb[j].w * rb * gg.w); o8b[64 * j] = z; }
}
__device__ __forceinline__ void rms_row_f32(int lane, float* xrow, const float* g) {
    f32x4* xr = (f32x4*)xrow + lane; const f32x4* gr = (const f32x4*)g + lane;
    f32x4 v[4]; float s = 0.f;
#pragma unroll
    for (int j = 0; j < 4; ++j) { v[j] = xr[64 * j]; s += (v[j].x * v[j].x + v[j].y * v[j].y) + (v[j].z * v[j].z + v[j].w * v[j].w); }
    const float r = 1.0f / sqrtf(wave_sum(s) * (1.f / D) + NORM_EPS);
#pragma unroll
    for (int j = 0; j < 4; ++j) { const f32x4 gg = gr[64 * j]; xr[64 * j] = v[j] * r * gg; }
}

__device__ __forceinline__ void fold_w4(const Ctx& C, const float* Wp, bf16* W4T) {
    LAS float* tw = (LAS float*)(C.lds + 131072);
    if (C.tid < 128) { const float x = (float)C.tid * (1.0f / 128.0f); tw[C.tid] = __builtin_amdgcn_cosf(x); tw[128 + C.tid] = -__builtin_amdgcn_sinf(x); }
    __syncthreads();
    for (int item = C.gtid; item < 1024 * 128; item += C.NT) {
        const int o = item & 1023, rest = item >> 10, g = rest >> 5, part = (rest >> 4) & 1, c0 = (rest & 15) * 8;
        const float* wp = Wp + (size_t)(g * 128) * 1024 + o; const LAS float* tb = tw + part * 128; float s[8]; int idx[8];
#pragma unroll
        for (int i = 0; i < 8; ++i) { s[i] = 0.f; idx[i] = 0; }
#pragma unroll 16
        for (int c2 = 0; c2 < 128; ++c2) { const float w = wp[(size_t)c2 * 1024];
#pragma unroll
            for (int i = 0; i < 8; ++i) { s[i] += tb[idx[i]] * w; idx[i] = (idx[i] + c0 + i) & 127; } }
        v4u ov; ov.x = cvt_pk_bf16(s[0], s[1]); ov.y = cvt_pk_bf16(s[2], s[3]); ov.z = cvt_pk_bf16(s[4], s[5]); ov.w = cvt_pk_bf16(s[6], s[7]);
        *(v4u*)(W4T + (size_t)o * 1024 + part * 512 + g * 128 + c0) = ov;
    }
    __syncthreads();
}
__device__ __forceinline__ void gen_dm(const Ctx& C, bf16* DM) {
    for (int idx = C.gtid; idx < 2 * 4096 * 512; idx += C.NT) {
        const int part = idx >> 21, n = (idx >> 9) & 4095, m0 = (idx & 511) * 8; float v[8];
#pragma unroll
        for (int j = 0; j < 8; ++j) { const float x = (float)((n * (m0 + j)) & 8191) * (1.0f / 8192.0f); v[j] = (part ? __builtin_amdgcn_sinf(x) : __builtin_amdgcn_cosf(x)) * (1.0f / 1024.0f); }
        v4u o; o.x = cvt_pk_bf16(v[0], v[1]); o.y = cvt_pk_bf16(v[2], v[3]); o.z = cvt_pk_bf16(v[4], v[5]); o.w = cvt_pk_bf16(v[6], v[7]);
        *(v4u*)(DM + (size_t)idx * 8) = o;
    }
}
__device__ __forceinline__ void fold_ft(const Ctx& C, bf16* FT) {
    constexpr int NCH = 512 * (NTOK / 16);
    for (int idx = C.gtid; idx < NCH; idx += C.NT) {
        const int c = idx / (NTOK / 16), q = idx % (NTOK / 16); int r0, m0, S;
        if (q < NTOK_P / 16) { S = SP; r0 = (q / (SP / 16)) * SP; m0 = (q % (SP / 16)) * 8; } else { const int q2 = q - NTOK_P / 16; S = SS; r0 = NTOK_P + (q2 / (SS / 16)) * SS; m0 = (q2 % (SS / 16)) * 8; }
        bf16* row = FT + (size_t)c * NTOK + r0;
        const v4u X = *(const v4u*)(row + m0), Z = *(const v4u*)(row + S - m0 - 8); const unsigned short p0 = (m0 > 0) ? row[S - m0] : (unsigned short)0;
        const float x[8] = {bflo(X.x), bfhi(X.x), bflo(X.y), bfhi(X.y), bflo(X.z), bfhi(X.z), bflo(X.w), bfhi(X.w)};
        const float z[8] = {bflo(Z.x), bfhi(Z.x), bflo(Z.y), bfhi(Z.y), bflo(Z.z), bfhi(Z.z), bflo(Z.w), bfhi(Z.w)};
        float xo[8], zo[8];
        const float pz = bflo((unsigned)p0);
        xo[0] = (m0 > 0) ? x[0] + pz : x[0];
#pragma unroll
        for (int t = 1; t < 8; ++t) { xo[t] = x[t] + z[8 - t]; zo[8 - t] = x[t] - z[8 - t]; }
        v4u XO; XO.x = cvt_pk_bf16(xo[0], xo[1]); XO.y = cvt_pk_bf16(xo[2], xo[3]); XO.z = cvt_pk_bf16(xo[4], xo[5]); XO.w = cvt_pk_bf16(xo[6], xo[7]);
        *(v4u*)(row + m0) = XO;
        bf16* zp = row + S - m0 - 8;
        zp[1] = (bf16)(cvt_pk_bf16(zo[1], 0.f) & 0xffffu); *(unsigned*)(zp + 2) = cvt_pk_bf16(zo[2], zo[3]); { v2u w; w.x = cvt_pk_bf16(zo[4], zo[5]); w.y = cvt_pk_bf16(zo[6], zo[7]); *(v2u*)(zp + 4) = w; }
        if (m0 > 0) row[S - m0] = (bf16)(cvt_pk_bf16(x[0] - pz, 0.f) & 0xffffu);
    }
}
__device__ __forceinline__ void gen_tab(const Ctx& C, float* tab, const float* decay_logit, float* lg2) {
    for (int idx = C.gtid; idx < 8192 * 32; idx += C.NT) {
        const int pos = idx >> 5, p = idx & 31;
        const double inv = exp(-(double)p * (9.210340371976184 / 32.0));
        double t = (double)pos * inv * 0.15915494309189535; t -= floor(t);
        const float x = (float)t; tab[2 * idx] = __builtin_amdgcn_cosf(x); tab[2 * idx + 1] = __builtin_amdgcn_sinf(x);
    }
    if (C.gtid < 16) { const float x = decay_logit[C.gtid]; const float ls = -log1pf(expf(-x)); lg2[C.gtid] = ls * 1.4426950408889634f; }
}
__device__ __forceinline__ void r1_phase(const Ctx& C, const bf16* QK, const bf16* VT, bf16* LS, const float* lg2) {
    const int tid = C.tid, w = C.wave, lane = C.lane, fr = lane & 15, fq = lane >> 4;
    LAS unsigned char* KT = C.lds;
    LAS float* LGL = (LAS float*)(C.lds + 128 * 272);
    if (tid < 16) LGL[tid] = lg2[tid];
    __syncthreads();
    int u = blockIdx.x; if (u >= NRU) return;
    const int e = 16 * w + fr; v4u kv[2]; bf16x8 va[4];
#pragma unroll
    for (int i = 0; i < 2; ++i) { const int q = tid + 512 * i; kv[i] = *(const v4u*)(QK + ((size_t)(NRU + u) * 128 + (q >> 3)) * 64 + (q & 7) * 8); }
#pragma unroll
    for (int ks = 0; ks < 4; ++ks) va[ks] = *(const bf16x8*)(VT + ((size_t)u * 128 + e) * 128 + ks * 32 + fq * 8);
    for (; u < NRU; u += gridDim.x) {
        const int h = u & 7; const float lf = LGL[h], lb = LGL[8 + h];
#pragma unroll
        for (int i = 0; i < 2; ++i) { const int q = tid + 512 * i, ap = q >> 3, dg = q & 7;
            const float sf = exp2_(lf * (float)(127 - ap)), sb = exp2_(lb * (float)ap);
            const float kf[8] = {bflo(kv[i].x), bfhi(kv[i].x), bflo(kv[i].y), bfhi(kv[i].y), bflo(kv[i].z), bfhi(kv[i].z), bflo(kv[i].w), bfhi(kv[i].w)};
#pragma unroll
            for (int j = 0; j < 8; ++j) { const int d = dg * 8 + j;
                *(LAS bf16*)(KT + d * 272 + ap * 2) = (bf16)(cvt_pk_bf16(kf[j] * sf, 0.f) & 0xffffu);
                *(LAS bf16*)(KT + (64 + d) * 272 + ap * 2) = (bf16)(cvt_pk_bf16(kf[j] * sb, 0.f) & 0xffffu); } }
        bf16x8 vc[4];
#pragma unroll
        for (int ks = 0; ks < 4; ++ks) vc[ks] = va[ks];
        LBAR();
        { const int un = u + gridDim.x, unx = un < NRU ? un : u;
#pragma unroll
          for (int i = 0; i < 2; ++i) { const int q = tid + 512 * i; kv[i] = *(const v4u*)(QK + ((size_t)(NRU + unx) * 128 + (q >> 3)) * 64 + (q & 7) * 8); }
#pragma unroll
          for (int ks = 0; ks < 4; ++ks) va[ks] = *(const bf16x8*)(VT + ((size_t)unx * 128 + e) * 128 + ks * 32 + fq * 8); }
        f32x4 acc[8];
#pragma unroll
        for (int c2 = 0; c2 < 8; c2 += 2) { bf16x8 kb[2][4];
#pragma unroll
            for (int cc = 0; cc < 2; ++cc)
#pragma unroll
                for (int ks = 0; ks < 4; ++ks) kb[cc][ks] = *(const LAS bf16x8*)(KT + (16 * (c2 + cc) + fr) * 272 + ks * 64 + fq * 16);
            __builtin_amdgcn_sched_barrier(0);
            f32x4 a0 = (f32x4){0.f, 0.f, 0.f, 0.f}, a1 = (f32x4){0.f, 0.f, 0.f, 0.f};
#pragma unroll
            for (int ks = 0; ks < 4; ++ks) { a0 = __builtin_amdgcn_mfma_f32_16x16x32_bf16(kb[0][ks], vc[ks], a0, 0, 0, 0); a1 = __builtin_amdgcn_mfma_f32_16x16x32_bf16(kb[1][ks], vc[ks], a1, 0, 0, 0); }
            acc[c2] = a0; acc[c2 + 1] = a1;
            __builtin_amdgcn_sched_barrier(0); }
        bf16* op = LS + ((size_t)u * 128 + e) * 128 + 4 * fq;
#pragma unroll
        for (int ct = 0; ct < 8; ++ct) { v2u wv; wv.x = cvt_pk_bf16(acc[ct][0], acc[ct][1]); wv.y = cvt_pk_bf16(acc[ct][2], acc[ct][3]); *(v2u*)(op + 16 * ct) = wv; }
        LBAR();
    }
}
struct ScanItem { bf16* base; int nch, ck0, dir; float dec; };
__device__ __forceinline__ ScanItem scan_item(int it, bf16* LS, const float* lg2) {
    const int ddg = it & 15, e = (it >> 4) & 127, h = (it >> 11) & 7, sq = it >> 14; ScanItem s;
    s.nch = sq < 4 ? 32 : 64; s.ck0 = sq < 4 ? sq * 32 : 128 + (sq - 4) * 64; s.dir = ddg >> 3;
    s.dec = exp2_(128.0f * lg2[s.dir * 8 + h]); s.base = LS + ((size_t)h * 128 + e) * 128 + ddg * 8; return s;
}
__device__ __forceinline__ void scan_step(const ScanItem& I, int i, const v4u ld, float (&s)[8]) {
    const int ck = I.ck0 + (I.dir ? I.nch - 1 - i : i);
    v4u o; o.x = cvt_pk_bf16(s[0], s[1]); o.y = cvt_pk_bf16(s[2], s[3]); o.z = cvt_pk_bf16(s[4], s[5]); o.w = cvt_pk_bf16(s[6], s[7]);
    *(v4u*)(I.base + (size_t)ck * 131072) = o;
    const float l[8] = {bflo(ld.x), bfhi(ld.x), bflo(ld.y), bfhi(ld.y), bflo(ld.z), bfhi(ld.z), bflo(ld.w), bfhi(ld.w)};
#pragma unroll
    for (int j = 0; j < 8; ++j) s[j] = s[j] * I.dec + l[j];
}
__device__ __forceinline__ void r2_phase(const Ctx& C, bf16* LS, const float* lg2) {
    constexpr int NIT = 12 * 8 * 128 * 16, NA = 131072;
    for (int t0 = C.gtid; t0 < NA; t0 += C.NT) {
        const bool hasB = t0 + NA < NIT;
        const ScanItem A = scan_item(t0, LS, lg2), B = scan_item(hasB ? t0 + NA : t0, LS, lg2);
        float sA[8], sB[8];
#pragma unroll
        for (int j = 0; j < 8; ++j) { sA[j] = 0.f; sB[j] = 0.f; }
        const int nmax = hasB ? (A.nch > B.nch ? A.nch : B.nch) : A.nch;
        for (int i0 = 0; i0 < nmax; i0 += 8) {
            const bool actA = i0 < A.nch, actB = hasB && i0 < B.nch;
            v4u ldA[8], ldB[8];
#pragma unroll
            for (int k = 0; k < 8; ++k) { const int i = i0 + k;
                ldA[k] = actA ? *(const v4u*)(A.base + (size_t)(A.ck0 + (A.dir ? A.nch - 1 - i : i)) * 131072) : (v4u){0u, 0u, 0u, 0u};
                ldB[k] = actB ? *(const v4u*)(B.base + (size_t)(B.ck0 + (B.dir ? B.nch - 1 - i : i)) * 131072) : (v4u){0u, 0u, 0u, 0u}; }
#pragma unroll
            for (int k = 0; k < 8; ++k) { if (actA) scan_step(A, i0 + k, ldA[k], sA); if (actB) scan_step(B, i0 + k, ldB[k], sB); }
        }
    }
}
struct R3Loads { bf16x8 qa[2], kb[8][2], bfr[8]; };
__device__ __forceinline__ void r3_issue_qk(R3Loads& L, const bf16* QK, int u, int w, int fr, int fq) {
#pragma unroll
    for (int ks = 0; ks < 2; ++ks) L.qa[ks] = *(const bf16x8*)(QK + ((size_t)u * 128 + 16 * w + fr) * 64 + ks * 32 + fq * 8);
#pragma unroll
    for (int ct = 0; ct < 8; ++ct)
#pragma unroll
        for (int ks = 0; ks < 2; ++ks) L.kb[ct][ks] = *(const bf16x8*)(QK + ((size_t)(NRU + u) * 128 + 16 * ct + fr) * 64 + ks * 32 + fq * 8);
}
__device__ __forceinline__ void r3_issue_b(R3Loads& L, const bf16* VT, const bf16* LS, int u, int w, int fr, int fq) {
#pragma unroll
    for (int ks = 0; ks < 4; ++ks) L.bfr[ks] = *(const bf16x8*)(VT + ((size_t)u * 128 + 16 * w + fr) * 128 + ks * 32 + fq * 8);
#pragma unroll
    for (int ks = 0; ks < 4; ++ks) L.bfr[4 + ks] = *(const bf16x8*)(LS + ((size_t)u * 128 + 16 * w + fr) * 128 + ks * 32 + fq * 8);
}
__device__ __forceinline__ void r3_phase(const Ctx& C, const bf16* QK, const bf16* VT, const bf16* LS, bf16* O, const float* lg2) {
    const int w = C.wave, lane = C.lane, fr = lane & 15, fq = lane >> 4;
    LAS unsigned char* A2 = C.lds; LAS float* RED = (LAS float*)(C.lds + 128 * 528);
    LAS float* LGL = (LAS float*)(C.lds + 128 * 528 + 8192);
    if (C.tid < 16) LGL[C.tid] = lg2[C.tid];
    __syncthreads();
    int u = blockIdx.x; if (u >= NRU) return;
    R3Loads cur; r3_issue_qk(cur, QK, u, w, fr, fq); r3_issue_b(cur, VT, LS, u, w, fr, fq);
    for (; u < NRU; u += gridDim.x) {
        const int ck = u >> 3, h = u & 7; const size_t t0 = (size_t)ck * 128; const float lf = LGL[h], lb = LGL[8 + h];
        const int a = 16 * w + fr;
#pragma unroll
        for (int ct = 0; ct < 8; ++ct) { f32x4 sc = (f32x4){0.f, 0.f, 0.f, 0.f};
#pragma unroll
            for (int ks = 0; ks < 2; ++ks) sc = __builtin_amdgcn_mfma_f32_16x16x32_bf16(cur.kb[ct][ks], cur.qa[ks], sc, 0, 0, 0);
            float p[4];
#pragma unroll
            for (int j = 0; j < 4; ++j) { const int df = a - (16 * ct + 4 * fq + j); const float dcy = df >= 0 ? exp2_(lf * (float)df) : exp2_(lb * (float)(-df)); p[j] = sc[j] * dcy; }
            v2u wv; wv.x = cvt_pk_bf16(p[0], p[1]); wv.y = cvt_pk_bf16(p[2], p[3]); *(LAS v2u*)(A2 + a * 528 + (16 * ct + 4 * fq) * 2) = wv; }
        { const float gf = exp2_(lf * (float)(a + 1)), gb = exp2_(lb * (float)(128 - a));
#pragma unroll
          for (int ks = 0; ks < 2; ++ks) { const v4u qv = __builtin_bit_cast(v4u, cur.qa[ks]);
              const float qf[8] = {bflo(qv.x), bfhi(qv.x), bflo(qv.y), bfhi(qv.y), bflo(qv.z), bfhi(qv.z), bflo(qv.w), bfhi(qv.w)};
              v4u f, b; f.x = cvt_pk_bf16(qf[0] * gf, qf[1] * gf); f.y = cvt_pk_bf16(qf[2] * gf, qf[3] * gf); f.z = cvt_pk_bf16(qf[4] * gf, qf[5] * gf); f.w = cvt_pk_bf16(qf[6] * gf, qf[7] * gf);
              b.x = cvt_pk_bf16(qf[0] * gb, qf[1] * gb); b.y = cvt_pk_bf16(qf[2] * gb, qf[3] * gb); b.z = cvt_pk_bf16(qf[4] * gb, qf[5] * gb); b.w = cvt_pk_bf16(qf[6] * gb, qf[7] * gb);
              *(LAS v4u*)(A2 + a * 528 + (128 + ks * 32 + fq * 8) * 2) = f; *(LAS v4u*)(A2 + a * 528 + (192 + ks * 32 + fq * 8) * 2) = b; } }
        LBAR();
        const int un = u + gridDim.x, unx = un < NRU ? un : u;
        r3_issue_qk(cur, QK, unx, w, fr, fq);
        f32x4 oc[8];
#pragma unroll
        for (int rt = 0; rt < 8; ++rt) { oc[rt] = (f32x4){0.f, 0.f, 0.f, 0.f};
#pragma unroll
            for (int ks = 0; ks < 8; ++ks) { const bf16x8 af = *(const LAS bf16x8*)(A2 + (16 * rt + fr) * 528 + ks * 64 + fq * 16); oc[rt] = __builtin_amdgcn_mfma_f32_16x16x32_bf16(cur.bfr[ks], af, oc[rt], 0, 0, 0); } }
        r3_issue_b(cur, VT, LS, unx, w, fr, fq);
#pragma unroll
        for (int rt = 0; rt < 8; ++rt) { float s1 = (oc[rt][0] + oc[rt][1]) + (oc[rt][2] + oc[rt][3]), s2 = (oc[rt][0] * oc[rt][0] + oc[rt][1] * oc[rt][1]) + (oc[rt][2] * oc[rt][2] + oc[rt][3] * oc[rt][3]);
            s1 += __shfl_xor(s1, 16); s1 += __shfl_xor(s1, 32); s2 += __shfl_xor(s2, 16); s2 += __shfl_xor(s2, 32);
            if (fq == 0) { RED[(16 * rt + fr) * 8 + w] = s1; RED[1024 + (16 * rt + fr) * 8 + w] = s2; } }
        LBAR();
        bf16* op = O + (t0 + fr) * 1024 + h * 128 + 16 * w + 4 * fq;
#pragma unroll
        for (int rt = 0; rt < 8; ++rt) { const LAS float* rp = RED + (16 * rt + fr) * 8;
            const f32x4 x0 = *(const LAS f32x4*)rp, x1 = *(const LAS f32x4*)(rp + 4), y0 = *(const LAS f32x4*)(rp + 1024), y1 = *(const LAS f32x4*)(rp + 1028);
            const float S1 = ((x0[0] + x0[1]) + (x0[2] + x0[3])) + ((x1[0] + x1[1]) + (x1[2] + x1[3])), S2 = ((y0[0] + y0[1]) + (y0[2] + y0[3])) + ((y1[0] + y1[1]) + (y1[2] + y1[3]));
            const float mu = S1 * (1.f / 128.f), var = fmaxf(S2 * (1.f / 128.f) - mu * mu, 0.f), rs = __builtin_amdgcn_rsqf(var + GN_EPS);
            v2u wv; wv.x = cvt_pk_bf16((oc[rt][0] - mu) * rs, (oc[rt][1] - mu) * rs); wv.y = cvt_pk_bf16((oc[rt][2] - mu) * rs, (oc[rt][3] - mu) * rs);
            *(v2u*)(op + (size_t)(16 * rt) * 1024) = wv; }
        LBAR();
    }
}
__device__ __forceinline__ void dft_nyquist(const Ctx& C, const bf16* FT, bf16* AB) {
    for (int it = C.gw; it < 12 * 512; it += C.NGW) {
        const int sq = it >> 9, c = it & 511, S = sq < 4 ? SP : SS, r0 = sq < 4 ? sq * SP : NTOK_P + (sq - 4) * SS;
        const bf16* src = FT + (size_t)c * NTOK + r0; float s = 0.f;
        for (int m0 = C.lane * 8; m0 < S / 2; m0 += 2048) { v4u v[4];
#pragma unroll
            for (int k = 0; k < 4; ++k) v[k] = *(const v4u*)(src + m0 + 512 * k);
#pragma unroll
            for (int k = 0; k < 4; ++k) s += (bflo(v[k].x) - bfhi(v[k].x)) + (bflo(v[k].y) - bfhi(v[k].y)) + (bflo(v[k].z) - bfhi(v[k].z)) + (bflo(v[k].w) - bfhi(v[k].w)); }
        s = (wave_sum(s) + bflo((unsigned)src[S / 2])) * (sq < 4 ? 0.001381067932f : 0.0009765625f);
        if (C.lane == 0) { AB[(size_t)(r0 + S / 2) * 1024 + c] = (bf16)(cvt_pk_bf16(s, 0.f) & 0xffffu); AB[(size_t)(r0 + S / 2) * 1024 + 512 + c] = 0; }
    }
}
__device__ __forceinline__ void conv_act(const Ctx& C, const bf16* H, bf16* ACT, const float* cw, const float* cb, int half) {
    for (int idx = C.gtid; idx < HALF_TOK * (FF / 8); idx += C.NT) {
        const int tl = idx / (FF / 8), ch0 = (idx % (FF / 8)) * 8, t = half * HALF_TOK + tl;
        const int S = t < NTOK_P ? SP : SS, pos = t & (S - 1), hc = 256 * (ch0 >> 7) + (ch0 & 127);
        const bf16* hr = H + (size_t)tl * (2 * FF) + hc;
        const v4u g1 = *(const v4u*)hr, vv = *(const v4u*)(hr + 128); v4u g0 = (v4u){0u, 0u, 0u, 0u}, g2 = (v4u){0u, 0u, 0u, 0u};
        if (pos > 0) g0 = *(const v4u*)(hr - 2 * FF);
        if (pos < S - 1) g2 = *(const v4u*)(hr + 2 * FF);
        const float a0[8] = {bflo(g0.x), bfhi(g0.x), bflo(g0.y), bfhi(g0.y), bflo(g0.z), bfhi(g0.z), bflo(g0.w), bfhi(g0.w)};
        const float a1[8] = {bflo(g1.x), bfhi(g1.x), bflo(g1.y), bfhi(g1.y), bflo(g1.z), bfhi(g1.z), bflo(g1.w), bfhi(g1.w)};
        const float a2[8] = {bflo(g2.x), bfhi(g2.x), bflo(g2.y), bfhi(g2.y), bflo(g2.z), bfhi(g2.z), bflo(g2.w), bfhi(g2.w)};
        const float av[8] = {bflo(vv.x), bfhi(vv.x), bflo(vv.y), bfhi(vv.y), bflo(vv.z), bfhi(vv.z), bflo(vv.w), bfhi(vv.w)};
        float r[8];
#pragma unroll
        for (int j = 0; j < 8; ++j) { const float x = cw[ch0 + j] * a0[j] + cw[FF + ch0 + j] * a1[j] + cw[2 * FF + ch0 + j] * a2[j] + cb[ch0 + j];
            r[j] = 0.5f * x * (1.0f + erff(x * 0.70710678118654752f)) * av[j]; }
        v4u o; o.x = cvt_pk_bf16(r[0], r[1]); o.y = cvt_pk_bf16(r[2], r[3]); o.z = cvt_pk_bf16(r[4], r[5]); o.w = cvt_pk_bf16(r[6], r[7]);
        *(v4u*)(ACT + (size_t)tl * FF + ch0) = o;
    }
}

__device__ __forceinline__ void dbg_dump(const Ctx& C, float* out, const bf16* X, const bf16* Y) {
    for (size_t j = C.gtid; j < (size_t)NTOK * D; j += C.NT) { float v = __uint_as_float((unsigned)X[j] << 16); if (Y) v += __uint_as_float((unsigned)Y[j] << 16); out[j] = v; }
}
__device__ __forceinline__ void final_rows(const Ctx& C, const bf16* X2B, const float* PS2, const float* g, float* out) {
    const int lane = C.lane; f32x4 gg[4];
#pragma unroll
    for (int k = 0; k < 2; ++k) { gg[2 * k] = *(const f32x4*)(g + k * 512 + lane * 8); gg[2 * k + 1] = *(const f32x4*)(g + k * 512 + lane * 8 + 4); }
    for (int m = C.gw; m < NTOK; m += 2 * C.NGW) {
        const int m2 = m + C.NGW; const bool has2 = m2 < NTOK; const int mb = has2 ? m2 : m;
        const v4u a0 = *(const v4u*)(X2B + (size_t)m * D + lane * 8), a1 = *(const v4u*)(X2B + (size_t)m * D + 512 + lane * 8);
        const v4u b0 = *(const v4u*)(X2B + (size_t)mb * D + lane * 8), b1 = *(const v4u*)(X2B + (size_t)mb * D + 512 + lane * 8);
        const f32x4 pa = *(const f32x4*)(PS2 + (size_t)m * 4), pb = *(const f32x4*)(PS2 + (size_t)mb * 4);
        const float ra = 1.0f / sqrtf(((pa[0] + pa[1]) + (pa[2] + pa[3])) * (1.f / D) + NORM_EPS), rb = 1.0f / sqrtf(((pb[0] + pb[1]) + (pb[2] + pb[3])) * (1.f / D) + NORM_EPS);
        float* oa = out + (size_t)m * D + lane * 8; float* ob = out + (size_t)mb * D + lane * 8;
        *(f32x4*)(oa) = (f32x4){bflo(a0.x), bfhi(a0.x), bflo(a0.y), bfhi(a0.y)} * ra * gg[0]; *(f32x4*)(oa + 4) = (f32x4){bflo(a0.z), bfhi(a0.z), bflo(a0.w), bfhi(a0.w)} * ra * gg[1];
        *(f32x4*)(oa + 512) = (f32x4){bflo(a1.x), bfhi(a1.x), bflo(a1.y), bfhi(a1.y)} * ra * gg[2]; *(f32x4*)(oa + 516) = (f32x4){bflo(a1.z), bfhi(a1.z), bflo(a1.w), bfhi(a1.w)} * ra * gg[3];
        if (has2) {
        *(f32x4*)(ob) = (f32x4){bflo(b0.x), bfhi(b0.x), bflo(b0.y), bfhi(b0.y)} * rb * gg[0]; *(f32x4*)(ob + 4) = (f32x4){bflo(b0.z), bfhi(b0.z), bflo(b0.w), bfhi(b0.w)} * rb * gg[1];
        *(f32x4*)(ob + 512) = (f32x4){bflo(b1.x), bfhi(b1.x), bflo(b1.y), bfhi(b1.y)} * rb * gg[2]; *(f32x4*)(ob + 516) = (f32x4){bflo(b1.z), bfhi(b1.z), bflo(b1.w), bfhi(b1.w)} * rb * gg[3]; }
    }
}
struct SchedG {
    pg8::StaticOrder so; const char* A; const char* B; size_t tsa, tsb; int pm_off;
    __device__ __forceinline__ bool next(int i, pg8::Unit& u) const { if (!so.next(i, u)) return false; u.pa = A + (size_t)u.pm * tsa; u.pb = B + (size_t)u.pn * tsb; u.pm += pm_off; u.r0 = 0; u.c0 = 0; u.aux = 0; u.S = 0; return true; }
};
struct SchedDFT {
    pg8::StaticOrder so; const char* DM; const char* FT; int ntile, S, tok0; size_t lda_b;
    __device__ __forceinline__ bool next(int i, pg8::Unit& u) const {
        if (!so.next(i, u)) return false;
        const int part = u.pm / ntile, nt = u.pm % ntile, sq = u.pn >> 1, hf = u.pn & 1;
        u.pa = DM + (size_t)part * ((size_t)4096 * 4096 * 2) + (size_t)nt * 256 * lda_b;
        u.pb = FT + ((size_t)(hf * 256) * NTOK + (size_t)(tok0 + sq * S + part * (S >> 1))) * 2;
        u.pm = nt; u.r0 = tok0 + sq * S; u.c0 = part * 512 + hf * 256; u.aux = part; u.S = S; return true;
    }
};

struct SchedChain {
    pg8::StaticOrder so; const char* AB; const char* ws;
    __device__ __forceinline__ bool next(int i, pg8::Unit& u) const {
        const int st = i & 3; if (!so.next(i >> 2, u)) return false;
        const size_t offA = (st == 2) ? WS_O : WS_XN;
        const size_t offB = WS_W4 - (size_t)(st == 1) * (4 * MiB) + (size_t)(st == 2) * (2 * MiB) - (size_t)(st == 3) * (2 * MiB);
        const char* A = ws + offA; if (st == 0) A = AB;
        u.pa = A + (size_t)u.pm * ((size_t)256 * 1024 * 2); u.pb = ws + offB + (size_t)u.pn * ((size_t)256 * 1024 * 2); u.aux = st; u.r0 = 0; u.c0 = 0; u.S = 0; return true;
    }
};
struct SchedUp {
    pg8::StaticOrder so; const char* XN2; const char* W;
    __device__ __forceinline__ bool next(int i, pg8::Unit& u) const {
        if (!so.next(i, u)) return false;
        u.c0 = 254 * u.pm - 1; u.r0 = 0; u.S = 0; u.aux = 0;
        u.pa = XN2 + ((long)u.c0) * 2048; u.pb = W + (size_t)u.pn * ((size_t)256 * 1024 * 2); return true;
    }
};

constexpr int NPHASE = 11;
struct Args { const float* in[14]; float* out; unsigned char* ws; int ph_lo, ph_hi; };
__global__ void __launch_bounds__(512, 2) fwd_kernel(Args args) {
    extern __shared__ __attribute__((aligned(16))) unsigned char lds_raw[];
    Ctx C; C.lds = (LAS unsigned char*)lds_raw; C.tid = threadIdx.x; C.lane = C.tid & 63; C.wave = __builtin_amdgcn_readfirstlane(C.tid >> 6);
    C.gw = blockIdx.x * 8 + C.wave; C.NGW = gridDim.x * 8; C.gtid = blockIdx.x * 512 + C.tid; C.NT = gridDim.x * 512;
    const int G = gridDim.x, bx = blockIdx.x;
    unsigned char* ws = args.ws;
    const float* x_p = args.in[0]; const float* x_s = args.in[1]; const float* norm1_g = args.in[2]; const float* w_in = args.in[3]; const float* w_four = args.in[4];
    const float* w_ret = args.in[5]; const float* w_out = args.in[6]; const float* decay_logit = args.in[7]; const float* norm2_g = args.in[8]; const float* w_up = args.in[9];
    const float* conv_w = args.in[10]; const float* conv_b = args.in[11]; const float* w_down = args.in[12]; const float* final_g = args.in[13];
    float* out = args.out;
    bf16* WQK = (bf16*)(ws + WS_WQK); bf16* WFV = (bf16*)(ws + WS_WFV); bf16* WGRET = (bf16*)(ws + WS_WGRET); bf16* WGA = (bf16*)(ws + WS_WGA); bf16* WGB = (bf16*)(ws + WS_WGB);
    bf16* W4 = (bf16*)(ws + WS_W4); bf16* WRET = (bf16*)(ws + WS_WRET); bf16* WOUT = (bf16*)(ws + WS_WOUT); bf16* WUP = (bf16*)(ws + WS_WUP); bf16* WDOWN = (bf16*)(ws + WS_WDOWN);
    float* TAB = (float*)(ws + WS_TAB); float* LG = (float*)(ws + WS_LG);
    bf16* XN = (bf16*)(ws + WS_XN); bf16* FV = (bf16*)(ws + WS_FV); bf16* QK = (bf16*)(ws + WS_QK); bf16* OB = (bf16*)(ws + WS_O); bf16* DM = (bf16*)(ws + WS_DM);
    bf16* BA = (bf16*)(ws + WS_BA); bf16* BB = (bf16*)(ws + WS_BB); bf16* ACT = (bf16*)(ws + WS_ACT); bf16* X2B = (bf16*)(ws + WS_X2B); float* PS1 = (float*)(ws + WS_PS1); float* PS2 = (float*)(ws + WS_PS2);
    bf16* AB = (bf16*)((unsigned char*)out + DO_AB);
#ifdef DBG_LS_IN_WS
    bf16* LS = (bf16*)(ws + WS_O);
#else
    bf16* LS = (bf16*)((unsigned char*)out + DO_LS);
#endif
    const bf16* VT = FV + (size_t)512 * NTOK;
    const int lo = args.ph_lo, hi = args.ph_hi;
    volatile LAS unsigned* XST = (volatile LAS unsigned*)(C.lds + LDS_BYTES - 16);
    if (C.tid < 2) XST[C.tid] = 0u;
    __syncthreads();
    XcdBarrier xbar; xbar.bar = (unsigned*)ws; xbar.x = 0; xbar.st = XST;
    if (lo == 0 && hi == NPHASE) xbar = xcd_barrier_post((unsigned*)ws, XST);
#ifdef DBG_STOP
    if (lo == 100) { dbg_dump(C, out, (const bf16*)(ws + DBG_X), DBG_Y ? (const bf16*)(ws + DBG_Y) : (const bf16*)nullptr); return; }
#endif
#define IN(k) (lo <= (k) && (k) < hi)
#define SEAM(k) do { if (IN(k) && IN((k) + 1)) { if (hi > NPHASE) cg::this_grid().sync(); else xcd_barrier(xbar); } } while (0)
#define GEMM_CALL(EPI, SCH, g, S, E) pg8::gemm_phase<EPI, SCH, true, true>(C.lds, g, S, E)
    const size_t T1K = (size_t)256 * 1024 * 2;

    if (IN(0)) {
        transpose_mat<1>(C, w_in, 1024, 5632, 512, 512, WQK, nullptr, 0.125f);
        transpose_mat<1>(C, w_in, 1024, 5632, 1024, 512, WQK + (size_t)512 * 1024);
        transpose_mat<0>(C, w_in, 1024, 5632, 0, 512, WFV);
        transpose_mat<0>(C, w_in, 1024, 5632, 1536, 1024, WFV + (size_t)512 * 1024);
        transpose_mat<0>(C, w_in, 1024, 5632, 2560, 1024, WGRET);
        transpose_mat<0>(C, w_in, 1024, 5632, 3584, 1024, WGA, nullptr, -1.4426950408889634f);
        transpose_mat<0>(C, w_in, 1024, 5632, 4608, 1024, WGB, nullptr, -1.4426950408889634f);
        transpose_mat<0>(C, w_ret, 1024, 1024, 0, 1024, WRET);
        transpose_mat<0>(C, w_out, 1024, 1024, 0, 1024, WOUT);
        transpose_mat<2>(C, w_up, 1024, 5632, 0, 5632, WUP, norm2_g);
        transpose_mat<0>(C, w_down, 2816, 1024, 0, 1024, WDOWN);
        fold_w4(C, w_four, W4);
        gen_tab(C, TAB, decay_logit, LG);
        for (int m = C.gw; m < NTOK; m += 2 * C.NGW) { const int m2 = (m + C.NGW < NTOK) ? m + C.NGW : m;
            rms_row2_to_bf16(C.lane, (m < NTOK_P ? x_p + (size_t)m * D : x_s + (size_t)(m - NTOK_P) * D), (m2 < NTOK_P ? x_p + (size_t)m2 * D : x_s + (size_t)(m2 - NTOK_P) * D), norm1_g, XN + (size_t)m * D, XN + (size_t)m2 * D); }
        gen_dm(C, DM);
        __syncthreads();
    }
    SEAM(0);
    if (IN(1)) {
        { pg8::Gemm g{1024, 1024, 1024}; SchedG S; S.so.init(NTOK / 256, 4, G, bx); S.A = (const char*)XN; S.B = (const char*)WQK; S.tsa = T1K; S.tsb = T1K; S.pm_off = 0;
          pg8::EpiRotary E{QK, TAB}; GEMM_CALL(pg8::EpiRotary, SchedG, g, S, E); }
        { pg8::Gemm g{1024, 1024, 1024}; SchedG S; S.so.init(6, NTOK / 256, G, bx); S.A = (const char*)WFV; S.B = (const char*)XN; S.tsa = T1K; S.tsb = T1K; S.pm_off = 0;
          pg8::EpiStoreFV E{FV, FV + (size_t)512 * NTOK}; GEMM_CALL(pg8::EpiStoreFV, SchedG, g, S, E); }
    }
    SEAM(1);
    if (IN(2)) { fold_ft(C, FV); r1_phase(C, QK, VT, LS, LG); }
    SEAM(2);
    if (IN(3)) {
        if (bx < G / 2) { Ctx C2 = C; C2.gtid = bx * 512 + C.tid; C2.NT = (G / 2) * 512; r2_phase(C2, LS, LG); }
#ifndef DBG_NO_DFT
        { pg8::Gemm g{8192, NTOK, SP / 2}; SchedDFT S; S.so.init(2 * 8, 4 * 2, G, (bx + G / 2) % G); S.DM = (const char*)DM; S.FT = (const char*)FV; S.ntile = 8; S.S = SP; S.tok0 = 0; S.lda_b = (size_t)8192 * 2;
          pg8::EpiDFT E{AB, FV, 1.41421356237f}; GEMM_CALL(pg8::EpiDFT, SchedDFT, g, S, E); }
        { pg8::Gemm g{4096, NTOK, SS / 2}; SchedDFT S; S.so.init(2 * 16, 8 * 2, G, bx); S.DM = (const char*)DM; S.FT = (const char*)FV; S.ntile = 16; S.S = SS; S.tok0 = NTOK_P; S.lda_b = (size_t)4096 * 2;
          pg8::EpiDFT E{AB, FV, 1.0f}; GEMM_CALL(pg8::EpiDFT, SchedDFT, g, S, E); }
#endif
        dft_nyquist(C, FV, AB);
    }
    SEAM(3);
    if (IN(4)) { r3_phase(C, QK, VT, LS, OB, LG); }
    SEAM(4);
    if (IN(5)) { pg8::Gemm g{1024, 1024, 1024}; SchedG S; S.so.init(NTOK / 256, 4, G, bx); S.A = (const char*)XN; S.B = (const char*)WGRET; S.tsa = T1K; S.tsb = T1K; S.pm_off = 0;
        pg8::EpiGateSilu E{OB}; GEMM_CALL(pg8::EpiGateSilu, SchedG, g, S, E); }
    SEAM(5);
    if (IN(6)) { pg8::Gemm g{1024, 1024, 1024}; SchedChain S; S.so.init(NTOK / 256, 4, G, bx); S.AB = (const char*)AB; S.ws = (const char*)ws;
        bf16* scr = (bf16*)(ws + WS_SCR) + (size_t)bx * (2 * 65536);
        pg8::EpiChain E{scr, scr + 65536, BA}; GEMM_CALL(pg8::EpiChain, SchedChain, g, S, E); }
    SEAM(6);
    PG8_LAS float* xlds = (PG8_LAS float*)(C.lds + 131072);
    if (IN(7)) {
        { pg8::Gemm g{1024, 1024, 1024}; SchedG S; S.so.init(NTOK_P / 256, 4, G, bx); S.A = (const char*)BA; S.B = (const char*)WOUT; S.tsa = T1K; S.tsb = T1K; S.pm_off = 0;
          pg8::EpiResBf<false> E{x_p, XN, PS1, 0, xlds}; GEMM_CALL(pg8::EpiResBf<false>, SchedG, g, S, E); }
        { pg8::Gemm g{1024, 1024, 1024}; SchedG S; S.so.init(NTOK_S / 256, 4, G, bx); S.A = (const char*)(BA + (size_t)NTOK_P * 1024); S.B = (const char*)WOUT; S.tsa = T1K; S.tsb = T1K; S.pm_off = 0;
          pg8::EpiResBf<false> E{x_s, XN, PS1, NTOK_P, xlds}; GEMM_CALL(pg8::EpiResBf<false>, SchedG, g, S, E); }
    }
    SEAM(7);
    const size_t TDN = (size_t)256 * FF * 2;
    if (IN(8)) { pg8::Gemm g{1024, 1024, 1024}; SchedUp S; S.so.init(323, 22, G, bx); S.XN2 = (const char*)XN; S.W = (const char*)WUP;
        pg8::EpiConvGLU E{ACT, conv_w, conv_b, PS1, xlds}; GEMM_CALL(pg8::EpiConvGLU, SchedUp, g, S, E); }
    SEAM(8);
    if (IN(9)) { pg8::Gemm g{FF, FF, FF}; SchedG S; S.so.init(NTOK / 256, 4, G, bx); S.A = (const char*)ACT; S.B = (const char*)WDOWN; S.tsa = TDN; S.tsb = TDN; S.pm_off = 0;
        pg8::EpiResBf<true> E{XN, X2B, PS2, 0, xlds}; GEMM_CALL(pg8::EpiResBf<true>, SchedG, g, S, E); }
    SEAM(9);
    if (IN(10)) { final_rows(C, X2B, PS2, final_g, out); }
#undef IN
#undef SEAM
}

extern "C" void kernel_launch(void* const* d_in, const int* in_sizes, int n_in, void* d_out, int out_size, void* d_ws, size_t ws_size, hipStream_t stream) {
    static int grid = 0;
    if (grid == 0) {
        if (n_in != 14 || out_size != NTOK * D || ws_size < WS_END) { fprintf(stderr, "kernel_launch: unexpected shapes (n_in %d out %d ws %zu)\n", n_in, out_size, ws_size); grid = -1; return; }
        int dev = 0, cus = 0, per_cu = 0;
        if (hipGetDevice(&dev) != hipSuccess || hipDeviceGetAttribute(&cus, hipDeviceAttributeMultiprocessorCount, dev) != hipSuccess) { grid = -1; return; }
        if (hipFuncSetAttribute((const void*)fwd_kernel, hipFuncAttributeMaxDynamicSharedMemorySize, LDS_BYTES) != hipSuccess) { fprintf(stderr, "kernel_launch: hipFuncSetAttribute failed\n"); grid = -1; return; }
        if (hipOccupancyMaxActiveBlocksPerMultiprocessor(&per_cu, (const void*)fwd_kernel, 512, LDS_BYTES) != hipSuccess || per_cu < 1) { fprintf(stderr, "kernel_launch: occupancy query says %d\n", per_cu); per_cu = 1; }
        (void)hipGetLastError();
        grid = cus * per_cu;
    }
    if (grid < 0) return;
    Args a{};
    for (int i = 0; i < 14; ++i) a.in[i] = (const float*)d_in[i];
    a.out = (float*)d_out; a.ws = (unsigned char*)d_ws;
#if MK_N_LAUNCHES == 1
    a.ph_lo = 0; a.ph_hi = NPHASE;
    if (hipMemsetAsync(d_ws, 0, 16384, stream) != hipSuccess) { fprintf(stderr, "kernel_launch: memset of the barrier words failed\n"); return; }
    void* kargs[] = {&a};
    hipError_t e = hipLaunchCooperativeKernel((const void*)fwd_kernel, dim3(grid), dim3(512), kargs, LDS_BYTES, stream);
    if (e != hipSuccess) fprintf(stderr, "cooperative launch failed: %s (grid %d)\n", hipGetErrorString(e), grid);
#else
#ifdef DBG_STOP
    for (int p = 0; p <= DBG_STOP; ++p) { a.ph_lo = p; a.ph_hi = p + 1; hipLaunchKernelGGL(fwd_kernel, dim3(grid), dim3(512), LDS_BYTES, stream, a); }
    if (DBG_X) { a.ph_lo = 100; a.ph_hi = 101; hipLaunchKernelGGL(fwd_kernel, dim3(grid), dim3(512), LDS_BYTES, stream, a); }
#else
    for (int p = 0; p < NPHASE; ++p) { a.ph_lo = p; a.ph_hi = p + 1; hipLaunchKernelGGL(fwd_kernel, dim3(grid), dim3(512), LDS_BYTES, stream, a); }
#endif
#endif
}
```

```cpp
#include <hip/hip_runtime.h>
#include <hip/hip_cooperative_groups.h>
#include <cstdio>
#include <cstdint>
#include <cmath>
namespace cg = cooperative_groups;

#ifndef MK_N_LAUNCHES
#define MK_N_LAUNCHES 1
#endif

namespace pg8 {
#define PG8_LAS __attribute__((address_space(3)))
typedef unsigned short bf16_t;
typedef short bf16x8 __attribute__((ext_vector_type(8)));
typedef float f32x4 __attribute__((ext_vector_type(4)));
typedef unsigned u32x4 __attribute__((ext_vector_type(4)));
typedef unsigned u32x2 __attribute__((ext_vector_type(2)));
constexpr int BM = 256, BK = 64, HALF = 128, HTB = HALF * BK * 2  , STAGE_BYTES = 8 * HTB, NXCD = 8, WGM = 8;

__host__ __device__ __forceinline__ int lds_byte(int r, int c) { const int st = (r >> 4) * 2 + (c >> 5), rr = r & 15, cc = c & 31, ob = rr * 64 + cc * 2; return st * 1024 + (ob ^ (((ob >> 9) & 1) << 5)); }
__host__ __device__ __forceinline__ void stage_rc(int b, int& R, int& C) { const int st = b / 1024, sb = b % 1024, swz = sb ^ (((sb >> 9) & 1) << 5); R = (st >> 1) * 16 + swz / 64; C = (st & 1) * 32 + (swz % 64) / 2; }
__host__ __device__ __forceinline__ int perm32(int rho) { const int n = rho >> 4, i = rho & 15; return 8 * (i >> 2) + 4 * n + (i & 3); }

struct Unit { int pm, pn; const char* pa; const char* pb; int r0, c0, aux, S; };
struct Gemm { int lda, ldb, K; };

struct StaticOrder {
    int nM, nN, nwg, G, c;
    __host__ __device__ void init(int nM_, int nN_, int G_, int c_) { nM = nM_; nN = nN_; nwg = nM * nN; G = G_; c = c_; }
    __host__ __device__ bool next(int i, Unit& u) const {
        const long L = (long)i * G + c; if (L >= nwg) return false;
        int wgid = (int)L; { const int q = nwg / NXCD, r = nwg % NXCD, xcd = wgid % NXCD, off = wgid / NXCD; wgid = (xcd < r ? xcd * (q + 1) : r * (q + 1) + (xcd - r) * q) + off; }
        const int nig = WGM * nN, gid = wgid / nig, fm = gid * WGM, gsz = (nM - fm) < WGM ? (nM - fm) : WGM;
        u.pm = fm + ((wgid % nig) % gsz); u.pn = (wgid % nig) / gsz; return true;
    }
};

typedef float f32x2_ __attribute__((ext_vector_type(2)));
typedef __bf16 bf16x2_ __attribute__((ext_vector_type(2)));
__device__ __forceinline__ unsigned cvt_pk_bf16(float lo, float hi) { const f32x2_ v = {lo, hi}; const bf16x2_ b = __builtin_convertvector(v, bf16x2_); return __builtin_bit_cast(unsigned, b); }
__device__ __forceinline__ float bflo(unsigned w) { return __uint_as_float(w << 16); }
__device__ __forceinline__ float bfhi(unsigned w) { return __uint_as_float(w & 0xffff0000u); }
__device__ __forceinline__ float sigmoidf_(float x) { return __builtin_amdgcn_rcpf(1.0f + __builtin_amdgcn_exp2f(-1.4426950408889634f * x)); }

#define EPI_LOOP_AM _Pragma("unroll") for (int ai = 0; ai < 2; ++ai) _Pragma("unroll") for (int m = 0; m < 4; ++m)
typedef f32x4 AccT[2][2][4][2];

struct EpiStore {
    static constexpr bool PERM = true, AFTER_DRAIN = false;
    bf16_t* O; int ldc;
    __device__ __forceinline__ void operator()(AccT& acc, const Unit& u, int wr, int wc, int fr, int fq) const {
        const int row0 = u.pm * BM + wr * 64 + fr, col0 = u.pn * BM + wc * 32 + 8 * fq;
        EPI_LOOP_AM { bf16_t* rowp = O + (size_t)(row0 + ai * HALF + m * 16) * ldc + col0;
#pragma unroll
            for (int bj = 0; bj < 2; ++bj) { const f32x4 v0 = acc[ai][bj][m][0], v1 = acc[ai][bj][m][1];
                u32x4 w; w.x = cvt_pk_bf16(v0[0], v0[1]); w.y = cvt_pk_bf16(v0[2], v0[3]); w.z = cvt_pk_bf16(v1[0], v1[1]); w.w = cvt_pk_bf16(v1[2], v1[3]);
                *(u32x4*)(rowp + bj * HALF) = w; } }
    }
};

struct EpiStoreFV {
    static constexpr bool PERM = true, AFTER_DRAIN = false;
    bf16_t* FT; bf16_t* VTt;
    __device__ __forceinline__ void operator()(AccT& acc, const Unit& u, int wr, int wc, int fr, int fq) const {
        const int row0 = u.pm * BM + wr * 64 + fr, col0 = u.pn * BM + wc * 32 + 8 * fq;
        bf16_t* base; size_t s_m, s_ai, s_bj;
        if (u.pm < 2) { base = FT + (size_t)row0 * 81920 + col0; s_m = (size_t)16 * 81920; s_ai = (size_t)128 * 81920; s_bj = 128; }
        else { const int r = row0 - 512; base = VTt + ((size_t)((col0 >> 7) * 8 + (r >> 7)) * 128 + (r & 127)) * 128 + (col0 & 127); s_m = 16 * 128; s_ai = (size_t)128 * 128; s_bj = (size_t)8 * 128 * 128; }
        EPI_LOOP_AM { bf16_t* rowp = base + ai * s_ai + m * s_m;
#pragma unroll
            for (int bj = 0; bj < 2; ++bj) { const f32x4 v0 = acc[ai][bj][m][0], v1 = acc[ai][bj][m][1];
                u32x4 w; w.x = cvt_pk_bf16(v0[0], v0[1]); w.y = cvt_pk_bf16(v0[2], v0[3]); w.z = cvt_pk_bf16(v1[0], v1[1]); w.w = cvt_pk_bf16(v1[2], v1[3]);
                *(u32x4*)(rowp + bj * s_bj) = w; } }
    }
};

struct EpiDFT {
    static constexpr bool PERM = true, AFTER_DRAIN = false;
    bf16_t* AB; const bf16_t* FT; float scale;
    __device__ __forceinline__ void operator()(AccT& acc, const Unit& u, int wr, int wc, int fr, int fq) const {
        const int n0 = u.pm * BM + wr * 64 + fr, col0 = u.c0 + wc * 32 + 8 * fq; const bool sinp = u.aux != 0;
        float fn[2][8];
#pragma unroll
        for (int bj = 0; bj < 2; ++bj)
#pragma unroll
            for (int k = 0; k < 8; ++k) fn[bj][k] = 0.f;
        if (!sinp) {
#pragma unroll
            for (int bj = 0; bj < 2; ++bj)
#pragma unroll
                for (int k = 0; k < 8; ++k) fn[bj][k] = bflo((unsigned)FT[(size_t)((col0 & 511) + bj * HALF + k) * 81920 + u.r0 + (u.S >> 1)]) * (1.0f / 1024.0f); }
        EPI_LOOP_AM { const int n = n0 + ai * HALF + m * 16; const float sg = (n & 1) ? -1.f : 1.f;
            const float s1 = sinp ? -sg * scale : scale, s2 = sinp ? -s1 : s1, sn = sg * scale;
            bf16_t* p1 = AB + (size_t)(u.r0 + n) * 1024 + col0; bf16_t* p2 = AB + (size_t)(u.r0 + u.S - n) * 1024 + col0;
#pragma unroll
            for (int bj = 0; bj < 2; ++bj) { const f32x4 v0 = acc[ai][bj][m][0], v1 = acc[ai][bj][m][1];
                float r[8] = {v0[0], v0[1], v0[2], v0[3], v1[0], v1[1], v1[2], v1[3]};
#pragma unroll
                for (int k = 0; k < 8; ++k) r[k] = r[k] * s1 + sn * fn[bj][k];
                u32x4 w; w.x = cvt_pk_bf16(r[0], r[1]); w.y = cvt_pk_bf16(r[2], r[3]); w.z = cvt_pk_bf16(r[4], r[5]); w.w = cvt_pk_bf16(r[6], r[7]);
                *(u32x4*)(p1 + bj * HALF) = w;
                if (n > 0) { const unsigned sm = sinp ? 0x80008000u : 0u; u32x4 x; x.x = w.x ^ sm; x.y = w.y ^ sm; x.z = w.z ^ sm; x.w = w.w ^ sm;
                    *(u32x4*)(p2 + bj * HALF) = x; } } }
    }
};

typedef float f32x2v __attribute__((ext_vector_type(2)));
struct EpiGateSilu {
    static constexpr bool PERM = true, AFTER_DRAIN = false;
    bf16_t* O;
    __device__ __forceinline__ void operator()(AccT& acc, const Unit& u, int wr, int wc, int fr, int fq) const {
        const int row0 = u.pm * BM + wr * 64 + fr, col0 = u.pn * BM + wc * 32 + 8 * fq;
        bf16_t* base = O + (size_t)row0 * 1024 + col0;
        u32x4 ov[2][4][2];
        EPI_LOOP_AM {
#pragma unroll
            for (int bj = 0; bj < 2; ++bj) ov[ai][m][bj] = *(const u32x4*)(base + (ai * HALF + m * 16) * 1024 + bj * HALF); }
        EPI_LOOP_AM {
#pragma unroll
            for (int bj = 0; bj < 2; ++bj) { const u32x4 o = ov[ai][m][bj]; const unsigned owd[4] = {o.x, o.y, o.z, o.w}; unsigned rw[4];
#pragma unroll
                for (int k = 0; k < 4; ++k) { const f32x4 gq = acc[ai][bj][m][k >> 1]; const f32x2v g = (k & 1) ? (f32x2v){gq[2], gq[3]} : (f32x2v){gq[0], gq[1]};
                    const f32x2v t = g * (-1.4426950408889634f); f32x2v e; e.x = __builtin_amdgcn_exp2f(t.x); e.y = __builtin_amdgcn_exp2f(t.y); const f32x2v d = e + 1.0f;
                    f32x2v s; s.x = __builtin_amdgcn_rcpf(d.x); s.y = __builtin_amdgcn_rcpf(d.y);
                    const f32x2v ovv = {bflo(owd[k]), bfhi(owd[k])}; const f32x2v r = (ovv * g) * s; rw[k] = cvt_pk_bf16(r.x, r.y); }
                u32x4 w; w.x = rw[0]; w.y = rw[1]; w.z = rw[2]; w.w = rw[3];
                *(u32x4*)(base + (ai * HALF + m * 16) * 1024 + bj * HALF) = w; } }
    }
};

template <int MODE> struct EpiGateSig {
    static constexpr bool PERM = true, AFTER_DRAIN = false;
    bf16_t* BA; const bf16_t* BB;
    __device__ __forceinline__ void operator()(AccT& acc, const Unit& u, int wr, int wc, int fr, int fq) const {
        const int row0 = u.pm * BM + wr * 64 + fr, col0 = u.pn * BM + wc * 32 + 8 * fq;
        const size_t off0 = (size_t)row0 * 1024 + col0;
#pragma unroll
        for (int ai = 0; ai < 2; ++ai) {
            u32x4 av[4][2], bv[4][2];
#pragma unroll
            for (int m = 0; m < 4; ++m)
#pragma unroll
                for (int bj = 0; bj < 2; ++bj) { av[m][bj] = *(const u32x4*)(BA + off0 + (ai * HALF + m * 16) * 1024 + bj * HALF); if (MODE == 1) bv[m][bj] = *(const u32x4*)(BB + off0 + (ai * HALF + m * 16) * 1024 + bj * HALF); }
#pragma unroll
            for (int m = 0; m < 4; ++m)
#pragma unroll
                for (int bj = 0; bj < 2; ++bj) { const f32x4 g0 = acc[ai][bj][m][0], g1 = acc[ai][bj][m][1]; const u32x4 a = av[m][bj];
                    float r[8]; const float gg[8] = {g0[0], g0[1], g0[2], g0[3], g1[0], g1[1], g1[2], g1[3]}; const float aa[8] = {bflo(a.x), bfhi(a.x), bflo(a.y), bfhi(a.y), bflo(a.z), bfhi(a.z), bflo(a.w), bfhi(a.w)};
                    if (MODE == 0) {
#pragma unroll
                        for (int k = 0; k < 8; ++k) r[k] = aa[k] * sigmoidf_(gg[k]);
                    } else { const u32x4 b = bv[m][bj]; const float bb[8] = {bflo(b.x), bfhi(b.x), bflo(b.y), bfhi(b.y), bflo(b.z), bfhi(b.z), bflo(b.w), bfhi(b.w)};
#pragma unroll
                        for (int k = 0; k < 8; ++k) r[k] = aa[k] + bb[k] * sigmoidf_(gg[k]);
                    }
                    u32x4 w; w.x = cvt_pk_bf16(r[0], r[1]); w.y = cvt_pk_bf16(r[2], r[3]); w.z = cvt_pk_bf16(r[4], r[5]); w.w = cvt_pk_bf16(r[6], r[7]);
                    *(u32x4*)(BA + off0 + (ai * HALF + m * 16) * 1024 + bj * HALF) = w; }
        }
    }
};

typedef float f32x2 __attribute__((ext_vector_type(2)));
struct EpiChain {
    static constexpr bool PERM = true, AFTER_DRAIN = false;
    bf16_t* SA; bf16_t* SB; bf16_t* BA;
    __device__ __forceinline__ void operator()(AccT& acc, const Unit& u, int wr, int wc, int fr, int fq) const {
        int frr = fr, fqq = fq; asm volatile("" : "+v"(frr), "+v"(fqq));
        const int st = u.aux; const int loff = (wr * 64 + frr) * 256 + wc * 32 + 8 * fqq;
        if (st == 0 || st == 2) { bf16_t* T = (st == 0) ? SA : SB;
            EPI_LOOP_AM {
#pragma unroll
                for (int bj = 0; bj < 2; ++bj) { const f32x4 v0 = acc[ai][bj][m][0], v1 = acc[ai][bj][m][1];
                    u32x4 w; w.x = cvt_pk_bf16(v0[0], v0[1]); w.y = cvt_pk_bf16(v0[2], v0[3]); w.z = cvt_pk_bf16(v1[0], v1[1]); w.w = cvt_pk_bf16(v1[2], v1[3]);
                    *(u32x4*)(T + loff + (ai * HALF + m * 16) * 256 + bj * HALF) = w; } }
        } else if (st == 1) {
            EPI_LOOP_AM {
#pragma unroll
                for (int bj = 0; bj < 2; ++bj) { const int lo = loff + (ai * HALF + m * 16) * 256 + bj * HALF; const u32x4 a = *(const u32x4*)(SA + lo);
                    const unsigned aw[4] = {a.x, a.y, a.z, a.w}; unsigned ow[4];
#pragma unroll
                    for (int k = 0; k < 4; ++k) { const f32x4 gq = acc[ai][bj][m][k >> 1]; const f32x2 g = (k & 1) ? (f32x2){gq[2], gq[3]} : (f32x2){gq[0], gq[1]};
                        f32x2 e; e.x = __builtin_amdgcn_exp2f(g.x); e.y = __builtin_amdgcn_exp2f(g.y);     const f32x2 d = e + 1.0f;
                        f32x2 s; s.x = __builtin_amdgcn_rcpf(d.x); s.y = __builtin_amdgcn_rcpf(d.y);
                        const f32x2 av = {bflo(aw[k]), bfhi(aw[k])}; const f32x2 r = av * s; ow[k] = cvt_pk_bf16(r.x, r.y); }
                    u32x4 w; w.x = ow[0]; w.y = ow[1]; w.z = ow[2]; w.w = ow[3]; *(u32x4*)(SA + lo) = w; } }
        } else {
            bf16_t* gout = BA + (size_t)(u.pm * BM + wr * 64 + frr) * 1024 + u.pn * BM + wc * 32 + 8 * fqq;
            EPI_LOOP_AM {
#pragma unroll
                for (int bj = 0; bj < 2; ++bj) { const int lo = loff + (ai * HALF + m * 16) * 256 + bj * HALF; const u32x4 a = *(const u32x4*)(SA + lo), b = *(const u32x4*)(SB + lo);
                    const unsigned aw[4] = {a.x, a.y, a.z, a.w}, bw[4] = {b.x, b.y, b.z, b.w}; unsigned ow[4];
#pragma unroll
                    for (int k = 0; k < 4; ++k) { const f32x4 gq = acc[ai][bj][m][k >> 1]; const f32x2 g = (k & 1) ? (f32x2){gq[2], gq[3]} : (f32x2){gq[0], gq[1]};
                        f32x2 e; e.x = __builtin_amdgcn_exp2f(g.x); e.y = __builtin_amdgcn_exp2f(g.y);     const f32x2 d = e + 1.0f;
                        f32x2 s; s.x = __builtin_amdgcn_rcpf(d.x); s.y = __builtin_amdgcn_rcpf(d.y);
                        const f32x2 av = {bflo(aw[k]), bfhi(aw[k])}, bv = {bflo(bw[k]), bfhi(bw[k])}; const f32x2 r = bv * s + av; ow[k] = cvt_pk_bf16(r.x, r.y); }
                    u32x4 w; w.x = ow[0]; w.y = ow[1]; w.z = ow[2]; w.w = ow[3]; *(u32x4*)(gout + (size_t)(ai * HALF + m * 16) * 1024 + bj * HALF) = w; } }
        }
    }
};


__device__ __forceinline__ f32x2 gelu_pk(f32x2 v) {
    const f32x2 av = __builtin_elementwise_abs(v), d = av * 0.2316418882f + 1.0f;
    f32x2 t; t.x = __builtin_amdgcn_rcpf(d.x); t.y = __builtin_amdgcn_rcpf(d.y);
    f32x2 q = t * 0.5307027145f + (-0.7265760135f); q = q * t + 0.7107068705f; q = q * t + (-0.142248368f); q = q * t + 0.127414796f; q = q * t;
    const f32x2 s = (v * v) * (-0.72134752044f);
    f32x2 e; e.x = __builtin_amdgcn_exp2f(s.x); e.y = __builtin_amdgcn_exp2f(s.y);
    const f32x2 m = v * (q * e), r = v - m;
    f32x2 o; o.x = v.x < 0.f ? m.x : r.x; o.y = v.y < 0.f ? m.y : r.y; return o;
}
__device__ __forceinline__ float dpp_ror1(float v)  { return __builtin_bit_cast(float, __builtin_amdgcn_update_dpp(0, __builtin_bit_cast(int, v), 0x121, 0xF, 0xF, false)); }
__device__ __forceinline__ float dpp_shr1_old(float old, float v) { return __builtin_bit_cast(float, __builtin_amdgcn_update_dpp(__builtin_bit_cast(int, old), __builtin_bit_cast(int, v), 0x111, 0xF, 0xF, false)); }
__device__ __forceinline__ float dpp_shl1_old(float old, float v) { return __builtin_bit_cast(float, __builtin_amdgcn_update_dpp(__builtin_bit_cast(int, old), __builtin_bit_cast(int, v), 0x101, 0xF, 0xF, false)); }
__device__ __forceinline__ float dpp_ror15(float v) { return __builtin_bit_cast(float, __builtin_amdgcn_update_dpp(0, __builtin_bit_cast(int, v), 0x12F, 0xF, 0xF, false)); }

struct EpiConvGLU {
    static constexpr bool PERM = true, AFTER_DRAIN = false;
    bf16_t* ACT; const float* cw; const float* cb; const float* PS; PG8_LAS float* xch;
    __device__ __forceinline__ void operator()(AccT& acc, const Unit& u, int wr, int wc, int fr, int fq) const {
        const int wid = wr * 4 + wc; PG8_LAS float* my = xch + wid * 128;
        EPI_LOOP_AM { const int gr = u.c0 + ai * HALF + wr * 64 + 4 * fr + m; const int grow = gr < 0 ? 0 : (gr >= 81920 ? 81919 : gr);
            const f32x4 p = *(const f32x4*)(PS + (size_t)grow * 4); const float rr = __builtin_amdgcn_rsqf(((p[0] + p[1]) + (p[2] + p[3])) * (1.0f / 1024.0f) + 1e-6f);
#pragma unroll
            for (int bj = 0; bj < 2; ++bj)
#pragma unroll
                for (int n = 0; n < 2; ++n) acc[ai][bj][m][n] = acc[ai][bj][m][n] * rr; }
        if (fr == 0) {
#pragma unroll
            for (int ai = 0; ai < 2; ++ai) { *(PG8_LAS f32x4*)(my + (ai * 2 + 0) * 32 + fq * 8) = acc[ai][0][0][0]; *(PG8_LAS f32x4*)(my + (ai * 2 + 0) * 32 + fq * 8 + 4) = acc[ai][0][0][1]; } }
        if (fr == 15) {
#pragma unroll
            for (int ai = 0; ai < 2; ++ai) { *(PG8_LAS f32x4*)(my + (ai * 2 + 1) * 32 + fq * 8) = acc[ai][0][3][0]; *(PG8_LAS f32x4*)(my + (ai * 2 + 1) * 32 + fq * 8 + 4) = acc[ai][0][3][1]; } }
        asm volatile("s_waitcnt lgkmcnt(0)" ::: "memory"); __builtin_amdgcn_s_barrier(); asm volatile("" ::: "memory");
        const int ch0 = u.pn * 128 + wc * 32 + fq * 8;
        const bool anyb = ((u.c0 + 256) >> 12) != (u.c0 >> 12);
        f32x4 cwv[2][4];
#pragma unroll
        for (int n = 0; n < 2; ++n) { cwv[n][0] = *(const f32x4*)(cw + ch0 + 4 * n); cwv[n][1] = *(const f32x4*)(cw + 2816 + ch0 + 4 * n); cwv[n][2] = *(const f32x4*)(cw + 5632 + ch0 + 4 * n); cwv[n][3] = *(const f32x4*)(cb + ch0 + 4 * n); }
#pragma unroll
        for (int ai = 0; ai < 2; ++ai) {
            const bool hasp = (wr == 1) || (ai == 1), hasn = (wr == 0) || (ai == 0);
            const PG8_LAS float* pp = xch + (wr == 1 ? (wid - 4) * 128 + (ai * 2 + 1) * 32 : (wid + 4) * 128 + (0 * 2 + 1) * 32) + fq * 8;
            const PG8_LAS float* pn_ = xch + (wr == 0 ? (wid + 4) * 128 + (ai * 2 + 0) * 32 : (wid - 4) * 128 + (1 * 2 + 0) * 32) + fq * 8;
            f32x4 upE[2], dnE[2];
#pragma unroll
            for (int n = 0; n < 2; ++n) { f32x4 pv = (f32x4){0.f, 0.f, 0.f, 0.f}, nv = (f32x4){0.f, 0.f, 0.f, 0.f}; if (hasp) pv = *(const PG8_LAS f32x4*)(pp + 4 * n); if (hasn) nv = *(const PG8_LAS f32x4*)(pn_ + 4 * n);
#pragma unroll
                for (int j = 0; j < 4; ++j) { upE[n][j] = dpp_shr1_old(pv[j], acc[ai][0][3][n][j]); dnE[n][j] = dpp_shl1_old(nv[j], acc[ai][0][0][n][j]); } }
#pragma unroll
            for (int m = 0; m < 4; ++m) {
                const int r = ai * HALF + wr * 64 + 4 * fr + m, gr = u.c0 + r; const int S = gr < 16384 ? 4096 : 8192, pos = gr & (S - 1);
                u32x4 w4;
#pragma unroll
                for (int n = 0; n < 2; ++n) {
                    f32x4 up = (m == 0) ? upE[n] : acc[ai][0][m > 0 ? m - 1 : 0][n], dn = (m == 3) ? dnE[n] : acc[ai][0][m < 3 ? m + 1 : 3][n];
                    if (anyb) { if (pos == 0) up = (f32x4){0.f, 0.f, 0.f, 0.f}; if (pos == S - 1) dn = (f32x4){0.f, 0.f, 0.f, 0.f}; }
                    const f32x4 x = cwv[n][0] * up + cwv[n][1] * acc[ai][0][m][n] + cwv[n][2] * dn + cwv[n][3], vv = acc[ai][1][m][n];
                    const f32x2 ga = gelu_pk((f32x2){x[0], x[1]}), gb = gelu_pk((f32x2){x[2], x[3]});
                    const unsigned lo = cvt_pk_bf16(ga.x * vv[0], ga.y * vv[1]), hi = cvt_pk_bf16(gb.x * vv[2], gb.y * vv[3]);
                    if (n == 0) { w4.x = lo; w4.y = hi; } else { w4.z = lo; w4.w = hi; }
                }
                if (r >= 1 && r <= 254 && gr < 81920) __builtin_nontemporal_store(w4, (u32x4*)(ACT + (size_t)gr * 2816 + ch0));
            }
        }
    }
};

template <bool BASE_BF16> struct EpiResBf {
    static constexpr bool PERM = true, AFTER_DRAIN = false;
    const void* base; bf16_t* Y; float* PS; int grow0; PG8_LAS float* xs;
    __device__ __forceinline__ void operator()(AccT& acc, const Unit& u, int wr, int wc, int fr, int fq) const {
        const int row0 = u.pm * BM + wr * 64 + fr, col0 = u.pn * BM + wc * 32 + 8 * fq;
        const size_t off0 = (size_t)row0 * 1024 + col0;
#pragma unroll
        for (int ai = 0; ai < 2; ++ai) {
            f32x4 bs[4][2][2];
#pragma unroll
            for (int m = 0; m < 4; ++m)
#pragma unroll
                for (int bj = 0; bj < 2; ++bj) { const size_t off = off0 + (size_t)(ai * HALF + m * 16) * 1024 + bj * HALF;
                    if (BASE_BF16) { const u32x4 w = *(const u32x4*)((const bf16_t*)base + off); bs[m][bj][0] = (f32x4){bflo(w.x), bfhi(w.x), bflo(w.y), bfhi(w.y)}; bs[m][bj][1] = (f32x4){bflo(w.z), bfhi(w.z), bflo(w.w), bfhi(w.w)}; }
                    else { bs[m][bj][0] = *(const f32x4*)((const float*)base + off); bs[m][bj][1] = *(const f32x4*)((const float*)base + off + 4); } }
#pragma unroll
            for (int m = 0; m < 4; ++m) { const size_t offy = off0 + (size_t)(ai * HALF + m * 16) * 1024 + (size_t)grow0 * 1024; f32x4 sv = (f32x4){0.f, 0.f, 0.f, 0.f};
#pragma unroll
                for (int bj = 0; bj < 2; ++bj) { const f32x4 y0 = bs[m][bj][0] + acc[ai][bj][m][0], y1 = bs[m][bj][1] + acc[ai][bj][m][1];
                    sv = sv + y0 * y0; sv = sv + y1 * y1;
                    u32x4 o; o.x = cvt_pk_bf16(y0[0], y0[1]); o.y = cvt_pk_bf16(y0[2], y0[3]); o.z = cvt_pk_bf16(y1[0], y1[1]); o.w = cvt_pk_bf16(y1[2], y1[3]); *(u32x4*)(Y + offy + bj * HALF) = o; }
                float s = (sv[0] + sv[1]) + (sv[2] + sv[3]);
                { const auto r16 = __builtin_amdgcn_permlane16_swap(__float_as_uint(s), __float_as_uint(s), false, false); s = __uint_as_float(r16[0]) + __uint_as_float(r16[1]); }
                { const auto r32 = __builtin_amdgcn_permlane32_swap(__float_as_uint(s), __float_as_uint(s), false, false); s = __uint_as_float(r32[0]) + __uint_as_float(r32[1]); }
                if (fq == 0) xs[(ai * HALF + wr * 64 + m * 16 + fr) * 4 + wc] = s; }
        }
        asm volatile("s_waitcnt lgkmcnt(0)" ::: "memory"); __builtin_amdgcn_s_barrier(); asm volatile("" ::: "memory");
        const int tid = (wr * 4 + wc) * 64 + fq * 16 + fr;
        if (tid < 256) { const f32x4 p = *(const PG8_LAS f32x4*)(xs + tid * 4); PS[(size_t)(grow0 + u.pm * BM + tid) * 4 + u.pn] = (p[0] + p[1]) + (p[2] + p[3]); }
    }
};

struct EpiRotary {
    static constexpr bool PERM = true, AFTER_DRAIN = false;
    bf16_t* QK; const float* tab;
    __device__ __forceinline__ void operator()(AccT& acc, const Unit& u, int wr, int wc, int fr, int fq) const {
        const int row0 = u.pm * BM + wr * 64 + fr; const int S = (u.pm < 64) ? 4096 : 8192; const float sc = (u.pn < 2) ? 0.125f : 1.0f;
        const int part = u.pn >> 1, hb = (u.pn & 1) * 4 + (wc >> 1), d0 = 32 * (wc & 1) + 8 * fq, p0 = 16 * (wc & 1) + 4 * fq;
        bf16_t* qbase = QK + ((((size_t)part * 640 + 2 * u.pm) * 8 + hb) * 128 + wr * 64 + fr) * 64 + d0;
        f32x4 tb[2][4][2];
        EPI_LOOP_AM { const int t = row0 + ai * HALF + m * 16, pos = t & (S - 1); const float* tp = tab + ((size_t)pos * 32 + p0) * 2; tb[ai][m][0] = *(const f32x4*)tp; tb[ai][m][1] = *(const f32x4*)(tp + 4); }
        EPI_LOOP_AM { const f32x4 t0 = tb[ai][m][0], t1 = tb[ai][m][1];
            const f32x4 cs = {t0[0], t0[2], t1[0], t1[2]}, sn = {t0[1], t0[3], t1[1], t1[3]};
#pragma unroll
            for (int bj = 0; bj < 2; ++bj) { const f32x4 x1 = acc[ai][bj][m][0], x2 = acc[ai][bj][m][1];
                const f32x4 y1 = x1 * cs - x2 * sn, y2 = x1 * sn + x2 * cs;
                u32x4 w; w.x = cvt_pk_bf16(y1[0], y1[1]); w.y = cvt_pk_bf16(y1[2], y1[3]); w.z = cvt_pk_bf16(y2[0], y2[1]); w.w = cvt_pk_bf16(y2[2], y2[3]);
                *(u32x4*)(qbase + ai * (8 * 128 * 64) + m * (16 * 64) + bj * (2 * 128 * 64)) = w; } }
    }
};

template <class E> struct ARowPerm { static constexpr bool value = false; };
template <> struct ARowPerm<EpiConvGLU> { static constexpr bool value = true; };
template <class Epi, class Sched, bool ALIGN_EPI = false, bool SP2 = false>
__device__ __forceinline__ void gemm_phase(PG8_LAS unsigned char* lds, const Gemm g, const Sched& S, const Epi& E) {
    const int tid = threadIdx.x, wid = __builtin_amdgcn_readfirstlane(tid >> 6), lane = tid & 63, wr = wid >> 2, wc = wid & 3, fr = lane & 15, fq = lane >> 4;
    const int K = g.K, nt = K / BK;
    unsigned voffA[2], voffB[2];
#pragma unroll
    for (int i = 0; i < 2; ++i) { int R, C; stage_rc(tid * 16 + i * 8192, R, C); const int Rb = Epi::PERM ? ((R & ~31) + perm32(R & 31)) : R;
        const int Ra = ARowPerm<Epi>::value ? ((R & ~63) + 4 * (R & 15) + ((R >> 4) & 3)) : R;
        voffA[i] = (unsigned)(Ra * g.lda + C) * 2u; voffB[i] = (unsigned)(Rb * g.ldb + C) * 2u; }
    const size_t kstep = (size_t)(BK * 2);
    const size_t hsA = (size_t)HALF * g.lda * 2, hsB = (size_t)HALF * g.ldb * 2;
    const unsigned ldsw = (unsigned)wid * 1024u;
    const int aoff = lds_byte(wr * 64 + fr, fq * 8), boff = lds_byte(wc * 32 + fr, fq * 8);
#define PG8_SA(b, h) (((b) * 2 + (h)) * HTB)
#define PG8_SB(b, h) ((4 + (b) * 2 + (h)) * HTB)
#define PG8_STAGE(bufoff, gbase, voff) do { _Pragma("unroll") for (int _i = 0; _i < 2; ++_i) \
        __builtin_amdgcn_global_load_lds((const unsigned*)((const char*)(gbase) + (voff)[_i]), (PG8_LAS unsigned*)(lds + (bufoff) + ldsw + _i * 8192), 16, 0, 0); } while (0)
#define PG8_LDA(dst, b, h) do { _Pragma("unroll") for (int m = 0; m < 4; ++m) _Pragma("unroll") for (int k = 0; k < 2; ++k) dst[m][k] = *(const PG8_LAS bf16x8*)(lds + PG8_SA(b, h) + aoff + m * 2048 + k * 1024); } while (0)
#define PG8_LDB(dst, b, h) do { _Pragma("unroll") for (int n = 0; n < 2; ++n) _Pragma("unroll") for (int k = 0; k < 2; ++k) dst[n][k] = *(const PG8_LAS bf16x8*)(lds + PG8_SB(b, h) + boff + n * 2048 + k * 1024); } while (0)
#define PG8_MMA(ai, bj, At, Bt) do { __builtin_amdgcn_s_setprio(1); _Pragma("unroll") for (int m = 0; m < 4; ++m) _Pragma("unroll") for (int n = 0; n < 2; ++n) _Pragma("unroll") for (int k = 0; k < 2; ++k) \
        acc[ai][bj][m][n] = __builtin_amdgcn_mfma_f32_16x16x32_bf16(Bt[n][k], At[m][k], acc[ai][bj][m][n], 0, 0, 0); __builtin_amdgcn_s_setprio(0); } while (0)
#define PG8_WAIT_V(n) asm volatile("s_waitcnt vmcnt(" #n ")" ::: "memory")
#define PG8_WAIT_L(n) asm volatile("s_waitcnt lgkmcnt(" #n ")" ::: "memory")
#define PG8_BAR __builtin_amdgcn_s_barrier()
#define PG8_SCHED __builtin_amdgcn_sched_barrier(0)
    Unit cur, nxt; int ui = 0;
    if (!S.next(0, cur)) return;
    f32x4 acc[2][2][4][2];
#pragma unroll
    for (int a = 0; a < 2; ++a)
#pragma unroll
        for (int b = 0; b < 2; ++b)
#pragma unroll
            for (int m = 0; m < 4; ++m)
#pragma unroll
                for (int n = 0; n < 2; ++n) acc[a][b][m][n] = (f32x4){0.f, 0.f, 0.f, 0.f};
    bf16x8 At[4][2], B0[2][2], B1[2][2];
    const char* cA = cur.pa; const char* cB = cur.pb;

    if constexpr (SP2) {
        PG8_STAGE(PG8_SB(0, 0), cB, voffB); PG8_STAGE(PG8_SB(0, 1), cB + hsB, voffB); PG8_STAGE(PG8_SA(0, 0), cA, voffA); PG8_STAGE(PG8_SA(0, 1), cA + hsA, voffA);
        if (wr == 1) PG8_BAR;
        PG8_WAIT_V(2); PG8_BAR;
        PG8_STAGE(PG8_SB(1, 0), cB + kstep, voffB); PG8_STAGE(PG8_SA(1, 0), cA + kstep, voffA); PG8_STAGE(PG8_SB(1, 1), cB + hsB + kstep, voffB);
        PG8_WAIT_V(6); PG8_BAR;
    } else {
        PG8_STAGE(PG8_SB(0, 0), cB, voffB); PG8_STAGE(PG8_SA(0, 0), cA, voffA); PG8_STAGE(PG8_SB(0, 1), cB + hsB, voffB); PG8_STAGE(PG8_SA(0, 1), cA + hsA, voffA);
        if (wr == 1) PG8_BAR;
        PG8_WAIT_V(4); PG8_BAR;
        PG8_STAGE(PG8_SB(1, 0), cB + kstep, voffB); PG8_STAGE(PG8_SA(1, 0), cA + kstep, voffA); PG8_STAGE(PG8_SB(1, 1), cB + hsB + kstep, voffB);
        PG8_WAIT_V(6); PG8_BAR;
    }
    for (;;) {
        const bool has_next = S.next(ui + 1, nxt);
        const char* nA = has_next ? nxt.pa : cA; const char* nB = has_next ? nxt.pb : cB;
        for (int t = 0; t < nt; t += 2) {
            const bool last = (t == nt - 2);
            const char* a1 = cA + (size_t)(t + 1) * kstep;
            const char* a2 = last ? nA : cA + (size_t)(t + 2) * kstep; const char* b2 = last ? nB : cB + (size_t)(t + 2) * kstep;
            const char* a3 = a2 + kstep; const char* b3 = b2 + kstep;

            if constexpr (SP2) {
            PG8_LDB(B0, 0, 0); PG8_LDB(B1, 0, 1); PG8_SCHED; PG8_LDA(At, 0, 0); PG8_STAGE(PG8_SA(1, 1), a1 + hsA, voffA);
            PG8_WAIT_V(8); PG8_WAIT_L(0); PG8_BAR; PG8_MMA(0, 0, At, B0); PG8_MMA(0, 1, At, B1); PG8_BAR; PG8_SCHED;
            PG8_LDA(At, 0, 1); PG8_STAGE(PG8_SB(0, 0), b2, voffB); PG8_STAGE(PG8_SB(0, 1), b2 + hsB, voffB); PG8_STAGE(PG8_SA(0, 0), a2, voffA);
            PG8_WAIT_V(8); PG8_WAIT_L(0); PG8_BAR; PG8_MMA(1, 0, At, B0); PG8_MMA(1, 1, At, B1); PG8_BAR; PG8_SCHED;
            PG8_LDB(B0, 1, 0); PG8_LDB(B1, 1, 1); PG8_SCHED; PG8_LDA(At, 1, 0); PG8_STAGE(PG8_SA(0, 1), a2 + hsA, voffA);
            PG8_WAIT_V(8); PG8_WAIT_L(0); PG8_BAR; PG8_MMA(0, 0, At, B0); PG8_MMA(0, 1, At, B1); PG8_BAR; PG8_SCHED;
            PG8_LDA(At, 1, 1); PG8_STAGE(PG8_SB(1, 0), b3, voffB); PG8_STAGE(PG8_SB(1, 1), b3 + hsB, voffB); PG8_STAGE(PG8_SA(1, 0), a3, voffA);
            PG8_WAIT_V(8); PG8_WAIT_L(0); PG8_BAR; PG8_MMA(1, 0, At, B0); PG8_MMA(1, 1, At, B1); PG8_BAR; PG8_SCHED;
            } else {
            PG8_LDB(B0, 0, 0); PG8_SCHED; PG8_LDA(At, 0, 0); PG8_STAGE(PG8_SA(1, 1), a1 + hsA, voffA);
            PG8_WAIT_L(8); PG8_BAR; PG8_WAIT_L(0); PG8_MMA(0, 0, At, B0); PG8_BAR; PG8_SCHED;
            PG8_LDB(B1, 0, 1); PG8_STAGE(PG8_SB(0, 0), b2, voffB);
            PG8_BAR; PG8_WAIT_L(0); PG8_MMA(0, 1, At, B1); PG8_BAR;
            PG8_LDA(At, 0, 1); PG8_STAGE(PG8_SA(0, 0), a2, voffA);
            PG8_BAR; PG8_WAIT_L(0); PG8_MMA(1, 0, At, B0); PG8_BAR; PG8_SCHED;
            PG8_STAGE(PG8_SB(0, 1), b2 + hsB, voffB);
            PG8_WAIT_V(6); PG8_BAR; PG8_MMA(1, 1, At, B1); PG8_BAR;
            PG8_LDB(B0, 1, 0); PG8_SCHED; PG8_LDA(At, 1, 0); PG8_STAGE(PG8_SA(0, 1), a2 + hsA, voffA);
            PG8_WAIT_L(8); PG8_BAR; PG8_WAIT_L(0); PG8_MMA(0, 0, At, B0); PG8_BAR; PG8_SCHED;
            PG8_LDB(B1, 1, 1); PG8_STAGE(PG8_SB(1, 0), b3, voffB);
            PG8_BAR; PG8_WAIT_L(0); PG8_MMA(0, 1, At, B1); PG8_BAR;
            PG8_LDA(At, 1, 1); PG8_STAGE(PG8_SA(1, 0), a3, voffA);
            PG8_BAR; PG8_WAIT_L(0); PG8_MMA(1, 0, At, B0); PG8_BAR; PG8_SCHED;
            PG8_STAGE(PG8_SB(1, 1), b3 + hsB, voffB);
            PG8_WAIT_V(6); PG8_BAR; PG8_MMA(1, 1, At, B1); PG8_BAR;
            }
        }
        if constexpr (ALIGN_EPI) { if (wr == 0) PG8_BAR; }
        if constexpr (!Epi::AFTER_DRAIN) { E(acc, cur, wr, wc, fr, fq); }
        if (!has_next) break;
#pragma unroll
        for (int a = 0; a < 2; ++a)
#pragma unroll
            for (int b = 0; b < 2; ++b)
#pragma unroll
                for (int m = 0; m < 4; ++m)
#pragma unroll
                    for (int n = 0; n < 2; ++n) acc[a][b][m][n] = (f32x4){0.f, 0.f, 0.f, 0.f};
        cur = nxt; cA = nA; cB = nB; ++ui;
        if constexpr (ALIGN_EPI) { if (wr == 1) PG8_BAR; }
    }
    PG8_WAIT_V(0);
    if constexpr (!ALIGN_EPI) { if (wr == 0) PG8_BAR; }
    PG8_BAR;
    if constexpr (Epi::AFTER_DRAIN) { E.fused(acc, cur, wr, wc, fr, fq, lds, wid, lane); }
#undef PG8_SA
#undef PG8_SB
#undef PG8_STAGE
#undef PG8_LDA
#undef PG8_LDB
#undef PG8_MMA
#undef PG8_WAIT_V
#undef PG8_WAIT_L
#undef PG8_BAR
#undef PG8_SCHED
}
}

constexpr int D = 1024, NTOK_P = 4 * 4096, NTOK_S = 8 * 8192, NTOK = NTOK_P + NTOK_S;
constexpr int SP = 4096, SS = 8192, FF = 2816, NCHUNK = NTOK / 128, NRU = NCHUNK * 8;
constexpr int HALF_TOK = NTOK / 2;
constexpr float NORM_EPS = 1e-6f, GN_EPS = 1e-5f;
constexpr size_t MiB = 1u << 20;
constexpr size_t WS_WQK = 1 * MiB, WS_WFV = 3 * MiB, WS_WGRET = 6 * MiB, WS_WGA = 8 * MiB, WS_WGB = 10 * MiB, WS_W4 = 12 * MiB, WS_WRET = 14 * MiB, WS_WOUT = 16 * MiB,
                 WS_WUP = 18 * MiB, WS_WDOWN = 29 * MiB, WS_TAB = 36 * MiB, WS_LG = 38 * MiB, WS_PS1 = 40 * MiB, WS_PS2 = 42 * MiB;
constexpr size_t WS_XN = 48 * MiB, WS_FV = 208 * MiB, WS_QK = 448 * MiB, WS_O = 608 * MiB, WS_DM = 768 * MiB, WS_SCR = 896 * MiB, WS_END = 960 * MiB;
constexpr size_t WS_BA = WS_FV, WS_BB = WS_QK;
constexpr size_t WS_ACT = 208 * MiB, WS_X2B = 648 * MiB;
constexpr size_t DO_AB = 0, DO_LS = 160 * MiB;
constexpr int LDS_BYTES = 147456;

#define LAS __attribute__((address_space(3)))
typedef unsigned short bf16;
typedef unsigned v4u __attribute__((ext_vector_type(4)));
typedef unsigned v2u __attribute__((ext_vector_type(2)));
typedef float f32x4 __attribute__((ext_vector_type(4)));
typedef short bf16x8 __attribute__((ext_vector_type(8)));
using pg8::cvt_pk_bf16; using pg8::bflo; using pg8::bfhi;
__device__ __forceinline__ float wave_sum(float v) {
#pragma unroll
    for (int o = 1; o < 64; o <<= 1) v += __shfl_xor(v, o);
    return v;
}
__device__ __forceinline__ float exp2_(float x) { return __builtin_amdgcn_exp2f(x); }

#define XB_TMO      128
#define XB_XCNT(j)  (256  + 64 * (j))
#define XB_XSUB(j)  (1280 + 64 * (j))
#define XB_XGEN(j)  (2304 + 64 * (j))
#define XB_TOP      3328
#define XB_TOPGEN   3392
#define XCD_BAR_WORDS 3456
#define XB_SPIN_CAP (1u << 18)

__device__ __forceinline__ unsigned xb_ld(unsigned* p)              { return __hip_atomic_load(p, __ATOMIC_RELAXED, __HIP_MEMORY_SCOPE_AGENT); }
__device__ __forceinline__ unsigned xb_add(unsigned* p, unsigned v) { return __hip_atomic_fetch_add(p, v, __ATOMIC_RELAXED, __HIP_MEMORY_SCOPE_AGENT); }
__device__ __forceinline__ unsigned xb_xcc_id() { return (unsigned)__builtin_amdgcn_s_getreg((3 << 11) | 20) & 0xFu; }
#define XB_SPIN(cond, bar) do { unsigned _sp = 0; while (cond) { __builtin_amdgcn_s_sleep(1); \
    if ((++_sp & 255u) == 0u) { if (xb_ld(&(bar)[XB_TMO])) break; if (_sp > XB_SPIN_CAP) { atomicAdd(&(bar)[XB_TMO], 1u); break; } } } } while (0)

struct XcdBarrier {
    unsigned* bar; unsigned x;
    volatile LAS unsigned* st;
};

__device__ __forceinline__ XcdBarrier xcd_barrier_post(unsigned* bar, volatile LAS unsigned* st) {
    XcdBarrier b; b.bar = bar; b.x = xb_xcc_id(); b.st = st;
    if (threadIdx.x == 0) (void)xb_add(&bar[XB_XCNT(b.x)], 1u);
    return b;
}
__device__ __forceinline__ void xcd_barrier_complete(unsigned* bar, unsigned x, unsigned& nloc, unsigned& nx) {
    const unsigned G = gridDim.x * gridDim.y * gridDim.z;
    unsigned sum, cnt, mine, sp = 0u;
    for (;;) {
        sum = 0u; cnt = 0u; mine = 0u;
#pragma unroll
        for (unsigned j = 0; j < 16; ++j) { const unsigned c = xb_ld(&bar[XB_XCNT(j)]); sum += c; cnt += (c > 0u) ? 1u : 0u; mine = (j == x) ? c : mine; }
        if (sum == G) break;
        __builtin_amdgcn_s_sleep(1);
        if ((++sp & 255u) == 0u) { if (xb_ld(&bar[XB_TMO])) break; if (sp > XB_SPIN_CAP) { atomicAdd(&bar[XB_TMO], 1u); break; } }
    }
    nloc = mine > 0u ? mine : 1u; nx = cnt > 0u ? cnt : 1u;
}

__device__ __forceinline__ void xcd_barrier(const XcdBarrier& b) {
    asm volatile("s_waitcnt vmcnt(0)" ::: "memory");
    __syncthreads();
    if (threadIdx.x == 0) {
        unsigned* bar = b.bar;
        __builtin_amdgcn_s_waitcnt(0);
        unsigned nloc = b.st[0], nx = b.st[1];
        if (nloc == 0u) { xcd_barrier_complete(bar, b.x, nloc, nx); b.st[0] = nloc; b.st[1] = nx; }
        const unsigned old = xb_add(&bar[XB_XSUB(b.x)], 1u);
        const unsigned gen = old / nloc;
        if (old + 1u == (gen + 1u) * nloc) {
            __builtin_amdgcn_fence(__ATOMIC_RELEASE, "agent");
            asm volatile("s_waitcnt vmcnt(0)" ::: "memory");
            const unsigned og = xb_add(&bar[XB_TOP], 1u);
            const unsigned tg = og / nx;
            if (og + 1u == (tg + 1u) * nx) xb_add(&bar[XB_TOPGEN], 1u);
            else XB_SPIN(xb_ld(&bar[XB_TOPGEN]) == tg, bar);
            __builtin_amdgcn_fence(__ATOMIC_ACQUIRE, "agent");
            xb_add(&bar[XB_XGEN(b.x)], 1u);
            asm volatile("s_waitcnt vmcnt(0)" ::: "memory");
        } else {
            XB_SPIN(xb_ld(&bar[XB_XGEN(b.x)]) == gen, bar);
            __builtin_amdgcn_fence(__ATOMIC_ACQUIRE, "agent");
            asm volatile("s_waitcnt vmcnt(0)" ::: "memory");
        }
    }
    __syncthreads();
}

#define LBAR() do { asm volatile("s_waitcnt lgkmcnt(0)" ::: "memory"); __builtin_amdgcn_s_barrier(); asm volatile("" ::: "memory"); } while (0)
struct Ctx { LAS unsigned char* lds; int tid, lane, wave, gw, NGW, gtid, NT; };

template <int MODE> __device__ __forceinline__ int rowmap(int n) {
    if (MODE == 1) { const int d = n & 63, p = d & 31; return (n & ~63) | ((p >> 2) << 3) | ((d >> 5) << 2) | (p & 3); }
    if (MODE == 2) { return n < FF ? 256 * (n / 128) + (n % 128) : 256 * ((n - FF) / 128) + 128 + ((n - FF) % 128); }
    return n;
}
template <int MODE> __device__ __forceinline__ void transpose_mat(const Ctx& C, const float* W, int Ksrc, int ldw, int col0, int ncols, bf16* WT, const float* kscale = nullptr, float sscale = 1.0f) {
    LAS float* scr = (LAS float*)(C.lds + C.wave * 16384);
    const int nblk = ncols / 32, nitems = (Ksrc / 64) * nblk, lane = C.lane;
    for (int it = C.gw; it < nitems; it += C.NGW) {
        const int kb = it / nblk, nb = it % nblk, k0 = 64 * kb, n0 = 32 * nb;
#pragma unroll 8
        for (int i = 0; i < 32; ++i) { const int kk = 2 * i + (lane >> 5); scr[kk * 33 + (lane & 31)] = W[(size_t)(k0 + kk) * ldw + col0 + n0 + (lane & 31)] * (kscale ? kscale[k0 + kk] * sscale : sscale); }
        asm volatile("s_waitcnt lgkmcnt(0)" ::: "memory");
        const int c = lane & 7;
#pragma unroll
        for (int j = 0; j < 4; ++j) { const int n = (lane >> 3) + 8 * j; const LAS float* s = scr + (8 * c) * 33 + n;
            v4u o; o.x = cvt_pk_bf16(s[0 * 33], s[1 * 33]); o.y = cvt_pk_bf16(s[2 * 33], s[3 * 33]); o.z = cvt_pk_bf16(s[4 * 33], s[5 * 33]); o.w = cvt_pk_bf16(s[6 * 33], s[7 * 33]);
            *(v4u*)(WT + (size_t)rowmap<MODE>(n0 + n) * Ksrc + k0 + 8 * c) = o; }
        asm volatile("s_waitcnt lgkmcnt(0)" ::: "memory");
    }
}
__device__ __forceinline__ void rms_row_to_bf16(int lane, const float* xrow, const float* g, bf16* orow) {
    const f32x4* xr = (const f32x4*)xrow + lane; const f32x4* gr = (const f32x4*)g + lane;
    f32x4 v[4]; float s = 0.f;
#pragma unroll
    for (int j = 0; j < 4; ++j) { v[j] = xr[64 * j]; s += (v[j].x * v[j].x + v[j].y * v[j].y) + (v[j].z * v[j].z + v[j].w * v[j].w); }
    const float r = 1.0f / sqrtf(wave_sum(s) * (1.f / D) + NORM_EPS);
    v2u* o8 = (v2u*)orow + lane;
#pragma unroll
    for (int j = 0; j < 4; ++j) { const f32x4 gg = gr[64 * j]; v2u w; w.x = cvt_pk_bf16(v[j].x * r * gg.x, v[j].y * r * gg.y); w.y = cvt_pk_bf16(v[j].z * r * gg.z, v[j].w * r * gg.w); o8[64 * j] = w; }
}
__device__ __forceinline__ void rms_row2_to_bf16(int lane, const float* xa, const float* xb, const float* g, bf16* oa, bf16* ob) {
    const f32x4* pa = (const f32x4*)xa + lane; const f32x4* pb = (const f32x4*)xb + lane; const f32x4* gr = (const f32x4*)g + lane;
    f32x4 va[4], vb[4]; float sa = 0.f, sb = 0.f;
#pragma unroll
    for (int j = 0; j < 4; ++j) { va[j] = pa[64 * j]; vb[j] = pb[64 * j]; }
#pragma unroll
    for (int j = 0; j < 4; ++j) { sa += (va[j].x * va[j].x + va[j].y * va[j].y) + (va[j].z * va[j].z + va[j].w * va[j].w); sb += (vb[j].x * vb[j].x + vb[j].y * vb[j].y) + (vb[j].z * vb[j].z + vb[j].w * vb[j].w); }
    const float ra = 1.0f / sqrtf(wave_sum(sa) * (1.f / D) + NORM_EPS), rb = 1.0f / sqrtf(wave_sum(sb) * (1.f / D) + NORM_EPS);
    v2u* o8a = (v2u*)oa + lane; v2u* o8b = (v2u*)ob + lane;
#pragma unroll
    for (int j = 0; j < 4; ++j) { const f32x4 gg = gr[64 * j]; v2u w; w.x = cvt_pk_bf16(va[j].x * ra * gg.x, va[j].y * ra * gg.y); w.y = cvt_pk_bf16(va[j].z * ra * gg.z, va[j].w * ra * gg.w); o8a[64 * j] = w;
        v2u z; z.x = cvt_pk_bf16(vb[j].x * rb * gg.x, vb[j].y * rb * gg.y); z.y = cvt_pk_bf16(vb[j].z * rb * gg.z, vb[j].w * rb * gg.w); o8b[64 * j] = z; }
}
__device__ __forceinline__ void rms_row_f32(int lane, float* xrow, const float* g) {
    f32x4* xr = (f32x4*)xrow + lane; const f32x4* gr = (const f32x4*)g + lane;
    f32x4 v[4]; float s = 0.f;
#pragma unroll
    for (int j = 0; j < 4; ++j) { v[j] = xr[64 * j]; s += (v[j].x * v[j].x + v[j].y * v[j].y) + (v[j].z * v[j].z + v[j].w * v[j].w); }
    const float r = 1.0f / sqrtf(wave_sum(s) * (1.f / D) + NORM_EPS);
#pragma unroll
    for (int j = 0; j < 4; ++j) { const f32x4 gg = gr[64 * j]; xr[64 * j] = v[j] * r * gg; }
}

__device__ __forceinline__ void fold_w4(const Ctx& C, const float* Wp, bf16* W4T) {
    LAS float* tw = (LAS float*)(C.lds + 131072);
    if (C.tid < 128) { const float x = (float)C.tid * (1.0f / 128.0f); tw[C.tid] = __builtin_amdgcn_cosf(x); tw[128 + C.tid] = -__builtin_amdgcn_sinf(x); }
    __syncthreads();
    for (int item = C.gtid; item < 1024 * 128; item += C.NT) {
        const int o = item & 1023, rest = item >> 10, g = rest >> 5, part = (rest >> 4) & 1, c0 = (rest & 15) * 8;
        const float* wp = Wp + (size_t)(g * 128) * 1024 + o; const LAS float* tb = tw + part * 128; float s[8]; int idx[8];
#pragma unroll
        for (int i = 0; i < 8; ++i) { s[i] = 0.f; idx[i] = 0; }
#pragma unroll 16
        for (int c2 = 0; c2 < 128; ++c2) { const float w = wp[(size_t)c2 * 1024];
#pragma unroll
            for (int i = 0; i < 8; ++i) { s[i] += tb[idx[i]] * w; idx[i] = (idx[i] + c0 + i) & 127; } }
        v4u ov; ov.x = cvt_pk_bf16(s[0], s[1]); ov.y = cvt_pk_bf16(s[2], s[3]); ov.z = cvt_pk_bf16(s[4], s[5]); ov.w = cvt_pk_bf16(s[6], s[7]);
        *(v4u*)(W4T + (size_t)o * 1024 + part * 512 + g * 128 + c0) = ov;
    }
    __syncthreads();
}
__device__ __forceinline__ void gen_dm(const Ctx& C, bf16* DM) {
    for (int idx = C.gtid; idx < 2 * 4096 * 512; idx += C.NT) {
        const int part = idx >> 21, n = (idx >> 9) & 4095, m0 = (idx & 511) * 8; float v[8];
#pragma unroll
        for (int j = 0; j < 8; ++j) { const float x = (float)((n * (m0 + j)) & 8191) * (1.0f / 8192.0f); v[j] = (part ? __builtin_amdgcn_sinf(x) : __builtin_amdgcn_cosf(x)) * (1.0f / 1024.0f); }
        v4u o; o.x = cvt_pk_bf16(v[0], v[1]); o.y = cvt_pk_bf16(v[2], v[3]); o.z = cvt_pk_bf16(v[4], v[5]); o.w = cvt_pk_bf16(v[6], v[7]);
        *(v4u*)(DM + (size_t)idx * 8) = o;
    }
}
__device__ __forceinline__ void fold_ft(const Ctx& C, bf16* FT) {
    constexpr int NCH = 512 * (NTOK / 16);
    for (int idx = C.gtid; idx < NCH; idx += C.NT) {
        const int c = idx / (NTOK / 16), q = idx % (NTOK / 16); int r0, m0, S;
        if (q < NTOK_P / 16) { S = SP; r0 = (q / (SP / 16)) * SP; m0 = (q % (SP / 16)) * 8; } else { const int q2 = q - NTOK_P / 16; S = SS; r0 = NTOK_P + (q2 / (SS / 16)) * SS; m0 = (q2 % (SS / 16)) * 8; }
        bf16* row = FT + (size_t)c * NTOK + r0;
        const v4u X = *(const v4u*)(row + m0), Z = *(const v4u*)(row + S - m0 - 8); const unsigned short p0 = (m0 > 0) ? row[S - m0] : (unsigned short)0;
        const float x[8] = {bflo(X.x), bfhi(X.x), bflo(X.y), bfhi(X.y), bflo(X.z), bfhi(X.z), bflo(X.w), bfhi(X.w)};
        const float z[8] = {bflo(Z.x), bfhi(Z.x), bflo(Z.y), bfhi(Z.y), bflo(Z.z), bfhi(Z.z), bflo(Z.w), bfhi(Z.w)};
        float xo[8], zo[8];
        const float pz = bflo((unsigned)p0);
        xo[0] = (m0 > 0) ? x[0] + pz : x[0];
#pragma unroll
        for (int t = 1; t < 8; ++t) { xo[t] = x[t] + z[8 - t]; zo[8 - t] = x[t] - z[8 - t]; }
        v4u XO; XO.x = cvt_pk_bf16(xo[0], xo[1]); XO.y = cvt_pk_bf16(xo[2], xo[3]); XO.z = cvt_pk_bf16(xo[4], xo[5]); XO.w = cvt_pk_bf16(xo[6], xo[7]);
        *(v4u*)(row + m0) = XO;
        bf16* zp = row + S - m0 - 8;
        zp[1] = (bf16)(cvt_pk_bf16(zo[1], 0.f) & 0xffffu); *(unsigned*)(zp + 2) = cvt_pk_bf16(zo[2], zo[3]); { v2u w; w.x = cvt_pk_bf16(zo[4], zo[5]); w.y = cvt_pk_bf16(zo[6], zo[7]); *(v2u*)(zp + 4) = w; }
        if (m0 > 0) row[S - m0] = (bf16)(cvt_pk_bf16(x[0] - pz, 0.f) & 0xffffu);
    }
}
__device__ __forceinline__ void gen_tab(const Ctx& C, float* tab, const float* decay_logit, float* lg2) {
    for (int idx = C.gtid; idx < 8192 * 32; idx += C.NT) {
        const int pos = idx >> 5, p = idx & 31;
        const double inv = exp(-(double)p * (9.210340371976184 / 32.0));
        double t = (double)pos * inv * 0.15915494309189535; t -= floor(t);
        const float x = (float)t; tab[2 * idx] = __builtin_amdgcn_cosf(x); tab[2 * idx + 1] = __builtin_amdgcn_sinf(x);
    }
    if (C.gtid < 16) { const float x = decay_logit[C.gtid]; const float ls = -log1pf(expf(-x)); lg2[C.gtid] = ls * 1.4426950408889634f; }
}
__device__ __forceinline__ void r1_phase(const Ctx& C, const bf16* QK, const bf16* VT, bf16* LS, const float* lg2) {
    const int tid = C.tid, w = C.wave, lane = C.lane, fr = lane & 15, fq = lane >> 4;
    LAS unsigned char* KT = C.lds;
    LAS float* LGL = (LAS float*)(C.lds + 128 * 272);
    if (tid < 16) LGL[tid] = lg2[tid];
    __syncthreads();
    int u = blockIdx.x; if (u >= NRU) return;
    const int e = 16 * w + fr; v4u kv[2]; bf16x8 va[4];
#pragma unroll
    for (int i = 0; i < 2; ++i) { const int q = tid + 512 * i; kv[i] = *(const v4u*)(QK + ((size_t)(NRU + u) * 128 + (q >> 3)) * 64 + (q & 7) * 8); }
#pragma unroll
    for (int ks = 0; ks < 4; ++ks) va[ks] = *(const bf16x8*)(VT + ((size_t)u * 128 + e) * 128 + ks * 32 + fq * 8);
    for (; u < NRU; u += gridDim.x) {
        const int h = u & 7; const float lf = LGL[h], lb = LGL[8 + h];
#pragma unroll
        for (int i = 0; i < 2; ++i) { const int q = tid + 512 * i, ap = q >> 3, dg = q & 7;
            const float sf = exp2_(lf * (float)(127 - ap)), sb = exp2_(lb * (float)ap);
            const float kf[8] = {bflo(kv[i].x), bfhi(kv[i].x), bflo(kv[i].y), bfhi(kv[i].y), bflo(kv[i].z), bfhi(kv[i].z), bflo(kv[i].w), bfhi(kv[i].w)};
#pragma unroll
            for (int j = 0; j < 8; ++j) { const int d = dg * 8 + j;
                *(LAS bf16*)(KT + d * 272 + ap * 2) = (bf16)(cvt_pk_bf16(kf[j] * sf, 0.f) & 0xffffu);
                *(LAS bf16*)(KT + (64 + d) * 272 + ap * 2) = (bf16)(cvt_pk_bf16(kf[j] * sb, 0.f) & 0xffffu); } }
        bf16x8 vc[4];
#pragma unroll
        for (int ks = 0; ks < 4; ++ks) vc[ks] = va[ks];
        LBAR();
        { const int un = u + gridDim.x, unx = un < NRU ? un : u;
#pragma unroll
          for (int i = 0; i < 2; ++i) { const int q = tid + 512 * i; kv[i] = *(const v4u*)(QK + ((size_t)(NRU + unx) * 128 + (q >> 3)) * 64 + (q & 7) * 8); }
#pragma unroll
          for (int ks = 0; ks < 4; ++ks) va[ks] = *(const bf16x8*)(VT + ((size_t)unx * 128 + e) * 128 + ks * 32 + fq * 8); }
        f32x4 acc[8];
#pragma unroll
        for (int c2 = 0; c2 < 8; c2 += 2) { bf16x8 kb[2][4];
#pragma unroll
            for (int cc = 0; cc < 2; ++cc)
#pragma unroll
                for (int ks = 0; ks < 4; ++ks) kb[cc][ks] = *(const LAS bf16x8*)(KT + (16 * (c2 + cc) + fr) * 272 + ks * 64 + fq * 16);
            __builtin_amdgcn_sched_barrier(0);
            f32x4 a0 = (f32x4){0.f, 0.f, 0.f, 0.f}, a1 = (f32x4){0.f, 0.f, 0.f, 0.f};
#pragma unroll
            for (int ks = 0; ks < 4; ++ks) { a0 = __builtin_amdgcn_mfma_f32_16x16x32_bf16(kb[0][ks], vc[ks], a0, 0, 0, 0); a1 = __builtin_amdgcn_mfma_f32_16x16x32_bf16(kb[1][ks], vc[ks], a1, 0, 0, 0); }
            acc[c2] = a0; acc[c2 + 1] = a1;
            __builtin_amdgcn_sched_barrier(0); }
        bf16* op = LS + ((size_t)u * 128 + e) * 128 + 4 * fq;
#pragma unroll
        for (int ct = 0; ct < 8; ++ct) { v2u wv; wv.x = cvt_pk_bf16(acc[ct][0], acc[ct][1]); wv.y = cvt_pk_bf16(acc[ct][2], acc[ct][3]); *(v2u*)(op + 16 * ct) = wv; }
        LBAR();
    }
}
struct ScanItem { bf16* base; int nch, ck0, dir; float dec; };
__device__ __forceinline__ ScanItem scan_item(int it, bf16* LS, const float* lg2) {
    const int ddg = it & 15, e = (it >> 4) & 127, h = (it >> 11) & 7, sq = it >> 14; ScanItem s;
    s.nch = sq < 4 ? 32 : 64; s.ck0 = sq < 4 ? sq * 32 : 128 + (sq - 4) * 64; s.dir = ddg >> 3;
    s.dec = exp2_(128.0f * lg2[s.dir * 8 + h]); s.base = LS + ((size_t)h * 128 + e) * 128 + ddg * 8; return s;
}
__device__ __forceinline__ void scan_step(const ScanItem& I, int i, const v4u ld, float (&s)[8]) {
    const int ck = I.ck0 + (I.dir ? I.nch - 1 - i : i);
    v4u o; o.x = cvt_pk_bf16(s[0], s[1]); o.y = cvt_pk_bf16(s[2], s[3]); o.z = cvt_pk_bf16(s[4], s[5]); o.w = cvt_pk_bf16(s[6], s[7]);
    *(v4u*)(I.base + (size_t)ck * 131072) = o;
    const float l[8] = {bflo(ld.x), bfhi(ld.x), bflo(ld.y), bfhi(ld.y), bflo(ld.z), bfhi(ld.z), bflo(ld.w), bfhi(ld.w)};
#pragma unroll
    for (int j = 0; j < 8; ++j) s[j] = s[j] * I.dec + l[j];
}
__device__ __forceinline__ void r2_phase(const Ctx& C, bf16* LS, const float* lg2) {
    constexpr int NIT = 12 * 8 * 128 * 16, NA = 131072;
    for (int t0 = C.gtid; t0 < NA; t0 += C.NT) {
        const bool hasB = t0 + NA < NIT;
        const ScanItem A = scan_item(t0, LS, lg2), B = scan_item(hasB ? t0 + NA : t0, LS, lg2);
        float sA[8], sB[8];
#pragma unroll
        for (int j = 0; j < 8; ++j) { sA[j] = 0.f; sB[j] = 0.f; }
        const int nmax = hasB ? (A.nch > B.nch ? A.nch : B.nch) : A.nch;
        for (int i0 = 0; i0 < nmax; i0 += 8) {
            const bool actA = i0 < A.nch, actB = hasB && i0 < B.nch;
            v4u ldA[8], ldB[8];
#pragma unroll
            for (int k = 0; k < 8; ++k) { const int i = i0 + k;
                ldA[k] = actA ? *(const v4u*)(A.base + (size_t)(A.ck0 + (A.dir ? A.nch - 1 - i : i)) * 131072) : (v4u){0u, 0u, 0u, 0u};
                ldB[k] = actB ? *(const v4u*)(B.base + (size_t)(B.ck0 + (B.dir ? B.nch - 1 - i : i)) * 131072) : (v4u){0u, 0u, 0u, 0u}; }
#pragma unroll
            for (int k = 0; k < 8; ++k) { if (actA) scan_step(A, i0 + k, ldA[k], sA); if (actB) scan_step(B, i0 + k, ldB[k], sB); }
        }
    }
}
struct R3Loads { bf16x8 qa[2], kb[8][2], bfr[8]; };
__device__ __forceinline__ void r3_issue_qk(R3Loads& L, const bf16* QK, int u, int w, int fr, int fq) {
#pragma unroll
    for (int ks = 0; ks < 2; ++ks) L.qa[ks] = *(const bf16x8*)(QK + ((size_t)u * 128 + 16 * w + fr) * 64 + ks * 32 + fq * 8);
#pragma unroll
    for (int ct = 0; ct < 8; ++ct)
#pragma unroll
        for (int ks = 0; ks < 2; ++ks) L.kb[ct][ks] = *(const bf16x8*)(QK + ((size_t)(NRU + u) * 128 + 16 * ct + fr) * 64 + ks * 32 + fq * 8);
}
__device__ __forceinline__ void r3_issue_b(R3Loads& L, const bf16* VT, const bf16* LS, int u, int w, int fr, int fq) {
#pragma unroll
    for (int ks = 0; ks < 4; ++ks) L.bfr[ks] = *(const bf16x8*)(VT + ((size_t)u * 128 + 16 * w + fr) * 128 + ks * 32 + fq * 8);
#pragma unroll
    for (int ks = 0; ks < 4; ++ks) L.bfr[4 + ks] = *(const bf16x8*)(LS + ((size_t)u * 128 + 16 * w + fr) * 128 + ks * 32 + fq * 8);
}
__device__ __forceinline__ void r3_phase(const Ctx& C, const bf16* QK, const bf16* VT, const bf16* LS, bf16* O, const float* lg2) {
    const int w = C.wave, lane = C.lane, fr = lane & 15, fq = lane >> 4;
    LAS unsigned char* A2 = C.lds; LAS float* RED = (LAS float*)(C.lds + 128 * 528);
    LAS float* LGL = (LAS float*)(C.lds + 128 * 528 + 8192);
    if (C.tid < 16) LGL[C.tid] = lg2[C.tid];
    __syncthreads();
    int u = blockIdx.x; if (u >= NRU) return;
    R3Loads cur; r3_issue_qk(cur, QK, u, w, fr, fq); r3_issue_b(cur, VT, LS, u, w, fr, fq);
    for (; u < NRU; u += gridDim.x) {
        const int ck = u >> 3, h = u & 7; const size_t t0 = (size_t)ck * 128; const float lf = LGL[h], lb = LGL[8 + h];
        const int a = 16 * w + fr;
#pragma unroll
        for (int ct = 0; ct < 8; ++ct) { f32x4 sc = (f32x4){0.f, 0.f, 0.f, 0.f};
#pragma unroll
            for (int ks = 0; ks < 2; ++ks) sc = __builtin_amdgcn_mfma_f32_16x16x32_bf16(cur.kb[ct][ks], cur.qa[ks], sc, 0, 0, 0);
            float p[4];
#pragma unroll
            for (int j = 0; j < 4; ++j) { const int df = a - (16 * ct + 4 * fq + j); const float dcy = df >= 0 ? exp2_(lf * (float)df) : exp2_(lb * (float)(-df)); p[j] = sc[j] * dcy; }
            v2u wv; wv.x = cvt_pk_bf16(p[0], p[1]); wv.y = cvt_pk_bf16(p[2], p[3]); *(LAS v2u*)(A2 + a * 528 + (16 * ct + 4 * fq) * 2) = wv; }
        { const float gf = exp2_(lf * (float)(a + 1)), gb = exp2_(lb * (float)(128 - a));
#pragma unroll
          for (int ks = 0; ks < 2; ++ks) { const v4u qv = __builtin_bit_cast(v4u, cur.qa[ks]);
              const float qf[8] = {bflo(qv.x), bfhi(qv.x), bflo(qv.y), bfhi(qv.y), bflo(qv.z), bfhi(qv.z), bflo(qv.w), bfhi(qv.w)};
              v4u f, b; f.x = cvt_pk_bf16(qf[0] * gf, qf[1] * gf); f.y = cvt_pk_bf16(qf[2] * gf, qf[3] * gf); f.z = cvt_pk_bf16(qf[4] * gf, qf[5] * gf); f.w = cvt_pk_bf16(qf[6] * gf, qf[7] * gf);
              b.x = cvt_pk_bf16(qf[0] * gb, qf[1] * gb); b.y = cvt_pk_bf16(qf[2] * gb, qf[3] * gb); b.z = cvt_pk_bf16(qf[4] * gb, qf[5] * gb); b.w = cvt_pk_bf16(qf[6] * gb, qf[7] * gb);
              *(LAS v4u*)(A2 + a * 528 + (128 + ks * 32 + fq * 8) * 2) = f; *(LAS v4u*)(A2 + a * 528 + (192 + ks * 32 + fq * 8) * 2) = b; } }
        LBAR();
        const int un = u + gridDim.x, unx = un < NRU ? un : u;
        r3_issue_qk(cur, QK, unx, w, fr, fq);
        f32x4 oc[8];
#pragma unroll
        for (int rt = 0; rt < 8; ++rt) { oc[rt] = (f32x4){0.f, 0.f, 0.f, 0.f};
#pragma unroll
            for (int ks = 0; ks < 8; ++ks) { const bf16x8 af = *(const LAS bf16x8*)(A2 + (16 * rt + fr) * 528 + ks * 64 + fq * 16); oc[rt] = __builtin_amdgcn_mfma_f32_16x16x32_bf16(cur.bfr[ks], af, oc[rt], 0, 0, 0); } }
        r3_issue_b(cur, VT, LS, unx, w, fr, fq);
#pragma unroll
        for (int rt = 0; rt < 8; ++rt) { float s1 = (oc[rt][0] + oc[rt][1]) + (oc[rt][2] + oc[rt][3]), s2 = (oc[rt][0] * oc[rt][0] + oc[rt][1] * oc[rt][1]) + (oc[rt][2] * oc[rt][2] + oc[rt][3] * oc[rt][3]);
            s1 += __shfl_xor(s1, 16); s1 += __shfl_xor(s1, 32); s2 += __shfl_xor(s2, 16); s2 += __shfl_xor(s2, 32);
            if (fq == 0) { RED[(16 * rt + fr) * 8 + w] = s1; RED[1024 + (16 * rt + fr) * 8 + w] = s2; } }
        LBAR();
        bf16* op = O + (t0 + fr) * 1024 + h * 128 + 16 * w + 4 * fq;
#pragma unroll
        for (int rt = 0; rt < 8; ++rt) { const LAS float* rp = RED + (16 * rt + fr) * 8;
            const f32x4 x0 = *(const LAS f32x4*)rp, x1 = *(const LAS f32x4*)(rp + 4), y0 = *(const LAS f32x4*)(rp + 1024), y1 = *(const LAS f32x4*)(rp + 1028);
            const float S1 = ((x0[0] + x0[1]) + (x0[2] + x0[3])) + ((x1[0] + x1[1]) + (x1[2] + x1[3])), S2 = ((y0[0] + y0[1]) + (y0[2] + y0[3])) + ((y1[0] + y1[1]) + (y1[2] + y1[3]));
            const float mu = S1 * (1.f / 128.f), var = fmaxf(S2 * (1.f / 128.f) - mu * mu, 0.f), rs = __builtin_amdgcn_rsqf(var + GN_EPS);
            v2u wv; wv.x = cvt_pk_bf16((oc[rt][0] - mu) * rs, (oc[rt][1] - mu) * rs); wv.y = cvt_pk_bf16((oc[rt][2] - mu) * rs, (oc[rt][3] - mu) * rs);
            *(v2u*)(op + (size_t)(16 * rt) * 1024) = wv; }
        LBAR();
    }
}
__device__ __forceinline__ void dft_nyquist(const Ctx& C, const bf16* FT, bf16* AB) {
    for (int it = C.gw; it < 12 * 512; it += C.NGW) {
        const int sq = it >> 9, c = it & 511, S = sq < 4 ? SP : SS, r0 = sq < 4 ? sq * SP : NTOK_P + (sq - 4) * SS;
        const bf16* src = FT + (size_t)c * NTOK + r0; float s = 0.f;
        for (int m0 = C.lane * 8; m0 < S / 2; m0 += 2048) { v4u v[4];
#pragma unroll
            for (int k = 0; k < 4; ++k) v[k] = *(const v4u*)(src + m0 + 512 * k);
#pragma unroll
            for (int k = 0; k < 4; ++k) s += (bflo(v[k].x) - bfhi(v[k].x)) + (bflo(v[k].y) - bfhi(v[k].y)) + (bflo(v[k].z) - bfhi(v[k].z)) + (bflo(v[k].w) - bfhi(v[k].w)); }
        s = (wave_sum(s) + bflo((unsigned)src[S / 2])) * (sq < 4 ? 0.001381067932f : 0.0009765625f);
        if (C.lane == 0) { AB[(size_t)(r0 + S / 2) * 1024 + c] = (bf16)(cvt_pk_bf16(s, 0.f) & 0xffffu); AB[(size_t)(r0 + S / 2) * 1024 + 512 + c] = 0; }
    }
}
__device__ __forceinline__ void conv_act(const Ctx& C, const bf16* H, bf16* ACT, const float* cw, const float* cb, int half) {
    for (int idx = C.gtid; idx < HALF_TOK * (FF / 8); idx += C.NT) {
        const int tl = idx / (FF / 8), ch0 = (idx % (FF / 8)) * 8, t = half * HALF_TOK + tl;
        const int S = t < NTOK_P ? SP : SS, pos = t & (S - 1), hc = 256 * (ch0 >> 7) + (ch0 & 127);
        const bf16* hr = H + (size_t)tl * (2 * FF) + hc;
        const v4u g1 = *(const v4u*)hr, vv = *(const v4u*)(hr + 128); v4u g0 = (v4u){0u, 0u, 0u, 0u}, g2 = (v4u){0u, 0u, 0u, 0u};
        if (pos > 0) g0 = *(const v4u*)(hr - 2 * FF);
        if (pos < S - 1) g2 = *(const v4u*)(hr + 2 * FF);
        const float a0[8] = {bflo(g0.x), bfhi(g0.x), bflo(g0.y), bfhi(g0.y), bflo(g0.z), bfhi(g0.z), bflo(g0.w), bfhi(g0.w)};
        const float a1[8] = {bflo(g1.x), bfhi(g1.x), bflo(g1.y), bfhi(g1.y), bflo(g1.z), bfhi(g1.z), bflo(g1.w), bfhi(g1.w)};
        const float a2[8] = {bflo(g2.x), bfhi(g2.x), bflo(g2.y), bfhi(g2.y), bflo(g2.z), bfhi(g2.z), bflo(g2.w), bfhi(g2.w)};
        const float av[8] = {bflo(vv.x), bfhi(vv.x), bflo(vv.y), bfhi(vv.y), bflo(vv.z), bfhi(vv.z), bflo(vv.w), bfhi(vv.w)};
        float r[8];
#pragma unroll
        for (int j = 0; j < 8; ++j) { const float x = cw[ch0 + j] * a0[j] + cw[FF + ch0 + j] * a1[j] + cw[2 * FF + ch0 + j] * a2[j] + cb[ch0 + j];
            r[j] = 0.5f * x * (1.0f + erff(x * 0.70710678118654752f)) * av[j]; }
        v4u o; o.x = cvt_pk_bf16(r[0], r[1]); o.y = cvt_pk_bf16(r[2], r[3]); o.z = cvt_pk_bf16(r[4], r[5]); o.w = cvt_pk_bf16(r[6], r[7]);
        *(v4u*)(ACT + (size_t)tl * FF + ch0) = o;
    }
}

__device__ __forceinline__ void dbg_dump(const Ctx& C, float* out, const bf16* X, const bf16* Y) {
    for (size_t j = C.gtid; j < (size_t)NTOK * D; j += C.NT) { float v = __uint_as_float((unsigned)X[j] << 16); if (Y) v += __uint_as_float((unsigned)Y[j] << 16); out[j] = v; }
}
__device__ __forceinline__ void final_rows(const Ctx& C, const bf16* X2B, const float* PS2, const float* g, float* out) {
    const int lane = C.lane; f32x4 gg[4];
#pragma unroll
    for (int k = 0; k < 2; ++k) { gg[2 * k] = *(const f32x4*)(g + k * 512 + lane * 8); gg[2 * k + 1] = *(const f32x4*)(g + k * 512 + lane * 8 + 4); }
    for (int m = C.gw; m < NTOK; m += 2 * C.NGW) {
        const int m2 = m + C.NGW; const bool has2 = m2 < NTOK; const int mb = has2 ? m2 : m;
        const v4u a0 = *(const v4u*)(X2B + (size_t)m * D + lane * 8), a1 = *(const v4u*)(X2B + (size_t)m * D + 512 + lane * 8);
        const v4u b0 = *(const v4u*)(X2B + (size_t)mb * D + lane * 8), b1 = *(const v4u*)(X2B + (size_t)mb * D + 512 + lane * 8);
        const f32x4 pa = *(const f32x4*)(PS2 + (size_t)m * 4), pb = *(const f32x4*)(PS2 + (size_t)mb * 4);
        const float ra = 1.0f / sqrtf(((pa[0] + pa[1]) + (pa[2] + pa[3])) * (1.f / D) + NORM_EPS), rb = 1.0f / sqrtf(((pb[0] + pb[1]) + (pb[2] + pb[3])) * (1.f / D) + NORM_EPS);
        float* oa = out + (size_t)m * D + lane * 8; float* ob = out + (size_t)mb * D + lane * 8;
        *(f32x4*)(oa) = (f32x4){bflo(a0.x), bfhi(a0.x), bflo(a0.y), bfhi(a0.y)} * ra * gg[0]; *(f32x4*)(oa + 4) = (f32x4){bflo(a0.z), bfhi(a0.z), bflo(a0.w), bfhi(a0.w)} * ra * gg[1];
        *(f32x4*)(oa + 512) = (f32x4){bflo(a1.x), bfhi(a1.x), bflo(a1.y), bfhi(a1.y)} * ra * gg[2]; *(f32x4*)(oa + 516) = (f32x4){bflo(a1.z), bfhi(a1.z), bflo(a1.w), bfhi(a1.w)} * ra * gg[3];
        if (has2) {
        *(f32x4*)(ob) = (f32x4){bflo(b0.x), bfhi(b0.x), bflo(b0.y), bfhi(b0.y)} * rb * gg[0]; *(f32x4*)(ob + 4) = (f32x4){bflo(b0.z), bfhi(b0.z), bflo(b0.w), bfhi(b0.w)} * rb * gg[1];
        *(f32x4*)(ob + 512) = (f32x4){bflo(b1.x), bfhi(b1.x), bflo(b1.y), bfhi(b1.y)} * rb * gg[2]; *(f32x4*)(ob + 516) = (f32x4){bflo(b1.z), bfhi(b1.z), bflo(b1.w), bfhi(b1.w)} * rb * gg[3]; }
    }
}
struct SchedG {
    pg8::StaticOrder so; const char* A; const char* B; size_t tsa, tsb; int pm_off;
    __device__ __forceinline__ bool next(int i, pg8::Unit& u) const { if (!so.next(i, u)) return false; u.pa = A + (size_t)u.pm * tsa; u.pb = B + (size_t)u.pn * tsb; u.pm += pm_off; u.r0 = 0; u.c0 = 0; u.aux = 0; u.S = 0; return true; }
};
struct SchedDFT {
    pg8::StaticOrder so; const char* DM; const char* FT; int ntile, S, tok0; size_t lda_b;
    __device__ __forceinline__ bool next(int i, pg8::Unit& u) const {
        if (!so.next(i, u)) return false;
        const int part = u.pm / ntile, nt = u.pm % ntile, sq = u.pn >> 1, hf = u.pn & 1;
        u.pa = DM + (size_t)part * ((size_t)4096 * 4096 * 2) + (size_t)nt * 256 * lda_b;
        u.pb = FT + ((size_t)(hf * 256) * NTOK + (size_t)(tok0 + sq * S + part * (S >> 1))) * 2;
        u.pm = nt; u.r0 = tok0 + sq * S; u.c0 = part * 512 + hf * 256; u.aux = part; u.S = S; return true;
    }
};

struct SchedChain {
    pg8::StaticOrder so; const char* AB; const char* ws;
    __device__ __forceinline__ bool next(int i, pg8::Unit& u) const {
        const int st = i & 3; if (!so.next(i >> 2, u)) return false;
        const size_t offA = (st == 2) ? WS_O : WS_XN;
        const size_t offB = WS_W4 - (size_t)(st == 1) * (4 * MiB) + (size_t)(st == 2) * (2 * MiB) - (size_t)(st == 3) * (2 * MiB);
        const char* A = ws + offA; if (st == 0) A = AB;
        u.pa = A + (size_t)u.pm * ((size_t)256 * 1024 * 2); u.pb = ws + offB + (size_t)u.pn * ((size_t)256 * 1024 * 2); u.aux = st; u.r0 = 0; u.c0 = 0; u.S = 0; return true;
    }
};
struct SchedUp {
    pg8::StaticOrder so; const char* XN2; const char* W;
    __device__ __forceinline__ bool next(int i, pg8::Unit& u) const {
        if (!so.next(i, u)) return false;
        u.c0 = 254 * u.pm - 1; u.r0 = 0; u.S = 0; u.aux = 0;
        u.pa = XN2 + ((long)u.c0) * 2048; u.pb = W + (size_t)u.pn * ((size_t)256 * 1024 * 2); return true;
    }
};

constexpr int NPHASE = 11;
struct Args { const float* in[14]; float* out; unsigned char* ws; int ph_lo, ph_hi; };
__global__ void __launch_bounds__(512, 2) fwd_kernel(Args args) {
    extern __shared__ __attribute__((aligned(16))) unsigned char lds_raw[];
    Ctx C; C.lds = (LAS unsigned char*)lds_raw; C.tid = threadIdx.x; C.lane = C.tid & 63; C.wave = __builtin_amdgcn_readfirstlane(C.tid >> 6);
    C.gw = blockIdx.x * 8 + C.wave; C.NGW = gridDim.x * 8; C.gtid = blockIdx.x * 512 + C.tid; C.NT = gridDim.x * 512;
    const int G = gridDim.x, bx = blockIdx.x;
    unsigned char* ws = args.ws;
    const float* x_p = args.in[0]; const float* x_s = args.in[1]; const float* norm1_g = args.in[2]; const float* w_in = args.in[3]; const float* w_four = args.in[4];
    const float* w_ret = args.in[5]; const float* w_out = args.in[6]; const float* decay_logit = args.in[7]; const float* norm2_g = args.in[8]; const float* w_up = args.in[9];
    const float* conv_w = args.in[10]; const float* conv_b = args.in[11]; const float* w_down = args.in[12]; const float* final_g = args.in[13];
    float* out = args.out;
    bf16* WQK = (bf16*)(ws + WS_WQK); bf16* WFV = (bf16*)(ws + WS_WFV); bf16* WGRET = (bf16*)(ws + WS_WGRET); bf16* WGA = (bf16*)(ws + WS_WGA); bf16* WGB = (bf16*)(ws + WS_WGB);
    bf16* W4 = (bf16*)(ws + WS_W4); bf16* WRET = (bf16*)(ws + WS_WRET); bf16* WOUT = (bf16*)(ws + WS_WOUT); bf16* WUP = (bf16*)(ws + WS_WUP); bf16* WDOWN = (bf16*)(ws + WS_WDOWN);
    float* TAB = (float*)(ws + WS_TAB); float* LG = (float*)(ws + WS_LG);
    bf16* XN = (bf16*)(ws + WS_XN); bf16* FV = (bf16*)(ws + WS_FV); bf16* QK = (bf16*)(ws + WS_QK); bf16* OB = (bf16*)(ws + WS_O); bf16* DM = (bf16*)(ws + WS_DM);
    bf16* BA = (bf16*)(ws + WS_BA); bf16* BB = (bf16*)(ws + WS_BB); bf16* ACT = (bf16*)(ws + WS_ACT); bf16* X2B = (bf16*)(ws + WS_X2B); float* PS1 = (float*)(ws + WS_PS1); float* PS2 = (float*)(ws + WS_PS2);
    bf16* AB = (bf16*)((unsigned char*)out + DO_AB);
#ifdef DBG_LS_IN_WS
    bf16* LS = (bf16*)(ws + WS_O);
#else
    bf16* LS = (bf16*)((unsigned char*)out + DO_LS);
#endif
    const bf16* VT = FV + (size_t)512 * NTOK;
    const int lo = args.ph_lo, hi = args.ph_hi;
    volatile LAS unsigned* XST = (volatile LAS unsigned*)(C.lds + LDS_BYTES - 16);
    if (C.tid < 2) XST[C.tid] = 0u;
    __syncthreads();
    XcdBarrier xbar; xbar.bar = (unsigned*)ws; xbar.x = 0; xbar.st = XST;
    if (lo == 0 && hi == NPHASE) xbar = xcd_barrier_post((unsigned*)ws, XST);
#ifdef DBG_STOP
    if (lo == 100) { dbg_dump(C, out, (const bf16*)(ws + DBG_X), DBG_Y ? (const bf16*)(ws + DBG_Y) : (const bf16*)nullptr); return; }
#endif
#define IN(k) (lo <= (k) && (k) < hi)
#define SEAM(k) do { if (IN(k) && IN((k) + 1)) { if (hi > NPHASE) cg::this_grid().sync(); else xcd_barrier(xbar); } } while (0)
#define GEMM_CALL(EPI, SCH, g, S, E) pg8::gemm_phase<EPI, SCH, true, true>(C.lds, g, S, E)
    const size_t T1K = (size_t)256 * 1024 * 2;

    if (IN(0)) {
        transpose_mat<1>(C, w_in, 1024, 5632, 512, 512, WQK, nullptr, 0.125f);
        transpose_mat<1>(C, w_in, 1024, 5632, 1024, 512, WQK + (size_t)512 * 1024);
        transpose_mat<0>(C, w_in, 1024, 5632, 0, 512, WFV);
        transpose_mat<0>(C, w_in, 1024, 5632, 1536, 1024, WFV + (size_t)512 * 1024);
        transpose_mat<0>(C, w_in, 1024, 5632, 2560, 1024, WGRET);
        transpose_mat<0>(C, w_in, 1024, 5632, 3584, 1024, WGA, nullptr, -1.4426950408889634f);
        transpose_mat<0>(C, w_in, 1024, 5632, 4608, 1024, WGB, nullptr, -1.4426950408889634f);
        transpose_mat<0>(C, w_ret, 1024, 1024, 0, 1024, WRET);
        transpose_mat<0>(C, w_out, 1024, 1024, 0, 1024, WOUT);
        transpose_mat<2>(C, w_up, 1024, 5632, 0, 5632, WUP, norm2_g);
        transpose_mat<0>(C, w_down, 2816, 1024, 0, 1024, WDOWN);
        fold_w4(C, w_four, W4);
        gen_tab(C, TAB, decay_logit, LG);
        for (int m = C.gw; m < NTOK; m += 2 * C.NGW) { const int m2 = (m + C.NGW < NTOK) ? m + C.NGW : m;
            rms_row2_to_bf16(C.lane, (m < NTOK_P ? x_p + (size_t)m * D : x_s + (size_t)(m - NTOK_P) * D), (m2 < NTOK_P ? x_p + (size_t)m2 * D : x_s + (size_t)(m2 - NTOK_P) * D), norm1_g, XN + (size_t)m * D, XN + (size_t)m2 * D); }
        gen_dm(C, DM);
        __syncthreads();
    }
    SEAM(0);
    if (IN(1)) {
        { pg8::Gemm g{1024, 1024, 1024}; SchedG S; S.so.init(NTOK / 256, 4, G, bx); S.A = (const char*)XN; S.B = (const char*)WQK; S.tsa = T1K; S.tsb = T1K; S.pm_off = 0;
          pg8::EpiRotary E{QK, TAB}; GEMM_CALL(pg8::EpiRotary, SchedG, g, S, E); }
        { pg8::Gemm g{1024, 1024, 1024}; SchedG S; S.so.init(6, NTOK / 256, G, bx); S.A = (const char*)WFV; S.B = (const char*)XN; S.tsa = T1K; S.tsb = T1K; S.pm_off = 0;
          pg8::EpiStoreFV E{FV, FV + (size_t)512 * NTOK}; GEMM_CALL(pg8::EpiStoreFV, SchedG, g, S, E); }
    }
    SEAM(1);
    if (IN(2)) { fold_ft(C, FV); r1_phase(C, QK, VT, LS, LG); }
    SEAM(2);
    if (IN(3)) {
        if (bx < G / 2) { Ctx C2 = C; C2.gtid = bx * 512 + C.tid; C2.NT = (G / 2) * 512; r2_phase(C2, LS, LG); }
#ifndef DBG_NO_DFT
        { pg8::Gemm g{8192, NTOK, SP / 2}; SchedDFT S; S.so.init(2 * 8, 4 * 2, G, (bx + G / 2) % G); S.DM = (const char*)DM; S.FT = (const char*)FV; S.ntile = 8; S.S = SP; S.tok0 = 0; S.lda_b = (size_t)8192 * 2;
          pg8::EpiDFT E{AB, FV, 1.41421356237f}; GEMM_CALL(pg8::EpiDFT, SchedDFT, g, S, E); }
        { pg8::Gemm g{4096, NTOK, SS / 2}; SchedDFT S; S.so.init(2 * 16, 8 * 2, G, bx); S.DM = (const char*)DM; S.FT = (const char*)FV; S.ntile = 16; S.S = SS; S.tok0 = NTOK_P; S.lda_b = (size_t)4096 * 2;
          pg8::EpiDFT E{AB, FV, 1.0f}; GEMM_CALL(pg8::EpiDFT, SchedDFT, g, S, E); }
#endif
        dft_nyquist(C, FV, AB);
    }
    SEAM(3);
    if (IN(4)) { r3_phase(C, QK, VT, LS, OB, LG); }
    SEAM(4);
    if (IN(5)) { pg8::Gemm g{1024, 1024, 1024}; SchedG S; S.so.init(NTOK / 256, 4, G, bx); S.A = (const char*)XN; S.B = (const char*)WGRET; S.tsa = T1K; S.tsb = T1K; S.pm_off = 0;
        pg8::EpiGateSilu E{OB}; GEMM_CALL(pg8::EpiGateSilu, SchedG, g, S, E); }
    SEAM(5);
    if (IN(6)) { pg8::Gemm g{1024, 1024, 1024}; SchedChain S; S.so.init(NTOK / 256, 4, G, bx); S.AB = (const char*)AB; S.ws = (const char*)ws;
        bf16* scr = (bf16*)(ws + WS_SCR) + (size_t)bx * (2 * 65536);
        pg8::EpiChain E{scr, scr + 65536, BA}; GEMM_CALL(pg8::EpiChain, SchedChain, g, S, E); }
    SEAM(6);
    PG8_LAS float* xlds = (PG8_LAS float*)(C.lds + 131072);
    if (IN(7)) {
        { pg8::Gemm g{1024, 1024, 1024}; SchedG S; S.so.init(NTOK_P / 256, 4, G, bx); S.A = (const char*)BA; S.B = (const char*)WOUT; S.tsa = T1K; S.tsb = T1K; S.pm_off = 0;
          pg8::EpiResBf<false> E{x_p, XN, PS1, 0, xlds}; GEMM_CALL(pg8::EpiResBf<false>, SchedG, g, S, E); }
        { pg8::Gemm g{1024, 1024, 1024}; SchedG S; S.so.init(NTOK_S / 256, 4, G, bx); S.A = (const char*)(BA + (size_t)NTOK_P * 1024); S.B = (const char*)WOUT; S.tsa = T1K; S.tsb = T1K; S.pm_off = 0;
          pg8::EpiResBf<false> E{x_s, XN, PS1, NTOK_P, xlds}; GEMM_CALL(pg8::EpiResBf<false>, SchedG, g, S, E); }
    }
    SEAM(7);
    const size_t TDN = (size_t)256 * FF * 2;
    if (IN(8)) { pg8::Gemm g{1024, 1024, 1024}; SchedUp S; S.so.init(323, 22, G, bx); S.XN2 = (const char*)XN; S.W = (const char*)WUP;
        pg8::EpiConvGLU E{ACT, conv_w, conv_b, PS1, xlds}; GEMM_CALL(pg8::EpiConvGLU, SchedUp, g, S, E); }
    SEAM(8);
    if (IN(9)) { pg8::Gemm g{FF, FF, FF}; SchedG S; S.so.init(NTOK / 256, 4, G, bx); S.A = (const char*)ACT; S.B = (const char*)WDOWN; S.tsa = TDN; S.tsb = TDN; S.pm_off = 0;
        pg8::EpiResBf<true> E{XN, X2B, PS2, 0, xlds}; GEMM_CALL(pg8::EpiResBf<true>, SchedG, g, S, E); }
    SEAM(9);
    if (IN(10)) { final_rows(C, X2B, PS2, final_g, out); }
#undef IN
#undef SEAM
}

extern "C" void kernel_launch(void* const* d_in, const int* in_sizes, int n_in, void* d_out, int out_size, void* d_ws, size_t ws_size, hipStream_t stream) {
    static int grid = 0;
    if (grid == 0) {
        if (n_in != 14 || out_size != NTOK * D || ws_size < WS_END) { fprintf(stderr, "kernel_launch: unexpected shapes (n_in %d out %d ws %zu)\n", n_in, out_size, ws_size); grid = -1; return; }
        int dev = 0, cus = 0, per_cu = 0;
        if (hipGetDevice(&dev) != hipSuccess || hipDeviceGetAttribute(&cus, hipDeviceAttributeMultiprocessorCount, dev) != hipSuccess) { grid = -1; return; }
        if (hipFuncSetAttribute((const void*)fwd_kernel, hipFuncAttributeMaxDynamicSharedMemorySize, LDS_BYTES) != hipSuccess) { fprintf(stderr, "kernel_launch: hipFuncSetAttribute failed\n"); grid = -1; return; }
        if (hipOccupancyMaxActiveBlocksPerMultiprocessor(&per_cu, (const void*)fwd_kernel, 512, LDS_BYTES) != hipSuccess || per_cu < 1) { fprintf(stderr, "kernel_launch: occupancy query says %d\n", per_cu); per_cu = 1; }
        (void)hipGetLastError();
        grid = cus * per_cu;
    }
    if (grid < 0) return;
    Args a{};
    for (int i = 0; i < 14; ++i) a.in[i] = (const float*)d_in[i];
    a.out = (float*)d_out; a.ws = (unsigned char*)d_ws;
#if MK_N_LAUNCHES == 1
    a.ph_lo = 0; a.ph_hi = NPHASE;
    if (hipMemsetAsync(d_ws, 0, 16384, stream) != hipSuccess) { fprintf(stderr, "kernel_launch: memset of the barrier words failed\n"); return; }
    void* kargs[] = {&a};
    hipError_t e = hipLaunchCooperativeKernel((const void*)fwd_kernel, dim3(grid), dim3(512), kargs, LDS_BYTES, stream);
    if (e != hipSuccess) fprintf(stderr, "cooperative launch failed: %s (grid %d)\n", hipGetErrorString(e), grid);
#else
#ifdef DBG_STOP
    for (int p = 0; p <= DBG_STOP; ++p) { a.ph_lo = p; a.ph_hi = p + 1; hipLaunchKernelGGL(fwd_kernel, dim3(grid), dim3(512), LDS_BYTES, stream, a); }
    if (DBG_X) { a.ph_lo = 100; a.ph_hi = 101; hipLaunchKernelGGL(fwd_kernel, dim3(grid), dim3(512), LDS_BYTES, stream, a); }
#else
    for (int p = 0; p < NPHASE; ++p) { a.ph_lo = p; a.ph_hi = p + 1; hipLaunchKernelGGL(fwd_kernel, dim3(grid), dim3(512), LDS_BYTES, stream, a); }
#endif
#endif
}
```
